# Optimizing an MI355X kernel written in HIP

```python
import jax, jax.numpy as jnp
from jax import lax
import numpy as np

D_MODEL = 2048
BATCH = 2
SEQ = 8192
DEPTH = 2

GRID_W = 64
CTX_LEN = 256
N_HEADS = 32
N_KV_HEADS = 4
HEAD_DIM = 64
GROUPS = N_HEADS // N_KV_HEADS
WINDOW = 128
BLOCK = 128
ROPE_THETA = 10000.0
D_CONV = D_MODEL
CONV_WIDTH = 3
D_FF = ((8 * D_MODEL // 3 + 255) // 256) * 256
Q_W = N_HEADS * HEAD_DIM
KV_W = N_KV_HEADS * HEAD_DIM
IN_SIZES = (Q_W, KV_W, KV_W, D_CONV, D_CONV, D_CONV, D_MODEL, D_MODEL)
IN_COLS = sum(IN_SIZES)
IN_OFFSETS = tuple(int(o) for o in np.cumsum(IN_SIZES)[:-1])
EPS = 1e-6
NEG = -1e30

kernel_name = "hybrid_conv_swa_dit_block"


def rmsnorm(x, g):
    xf = x.astype(jnp.float32)
    y = xf * lax.rsqrt(jnp.mean(xf * xf, axis=-1, keepdims=True) + EPS)
    return y.astype(x.dtype) * g


def modulate(x, g, shift, scale):
    return rmsnorm(x, g) * (1.0 + scale) + shift


def ada_split(cvec, w, b):
    m = jax.nn.silu(cvec) @ w + b
    return jnp.split(m, 6, axis=-1)


def rope_1d(x, pos):
    half = x.shape[-1] // 2
    freqs = ROPE_THETA ** (-jnp.arange(half, dtype=jnp.float32) / half)
    ang = pos[:, None] * freqs[None, :]
    cos = jnp.cos(ang)[None, :, None, :].astype(x.dtype)
    sin = jnp.sin(ang)[None, :, None, :].astype(x.dtype)
    x1, x2 = x[..., :half], x[..., half:]
    return jnp.concatenate([x1 * cos - x2 * sin, x2 * cos + x1 * sin], axis=-1)


def axial_rope(x, row, col):
    d = x.shape[-1] // 2
    return jnp.concatenate([rope_1d(x[..., :d], row), rope_1d(x[..., d:], col)], axis=-1)


def softmax_with_sink(logits, sink):
    s = jnp.broadcast_to(sink.astype(jnp.float32).reshape(N_KV_HEADS, GROUPS)[None, :, :, None, None],
                         logits.shape[:-1] + (1,))
    p = jax.nn.softmax(jnp.concatenate([logits, s], axis=-1), axis=-1)
    return p[..., :-1]


def context_attention(q, k, v, sink):
    b, n = q.shape[0], q.shape[1]
    qg = q.reshape(b, n, N_KV_HEADS, GROUPS, HEAD_DIM)
    s = jnp.einsum('bqkgd,bskd->bkgqs', qg, k).astype(jnp.float32) * (HEAD_DIM ** -0.5)
    p = softmax_with_sink(s, sink).astype(v.dtype)
    o = jnp.einsum('bkgqs,bskd->bqkgd', p, v)
    return o.reshape(b, n, Q_W)


def latent_window_attention(q, k, v, kc, vc, sink):
    b, s_len = q.shape[0], q.shape[1]
    nb = s_len // BLOCK
    qb = q.reshape(b, nb, BLOCK, N_KV_HEADS, GROUPS, HEAD_DIM).transpose(1, 0, 2, 3, 4, 5)

    def band(t):
        tp = jnp.pad(t, ((0, 0), (BLOCK, BLOCK), (0, 0), (0, 0)))
        tp = tp.reshape(b, nb + 2, BLOCK, N_KV_HEADS, HEAD_DIM)
        tb = jnp.concatenate([tp[:, :-2], tp[:, 1:-1], tp[:, 2:]], axis=2)
        return tb.transpose(1, 0, 2, 3, 4)

    kb, vb = band(k), band(v)
    bids = jnp.arange(nb, dtype=jnp.int32)
    scale = HEAD_DIM ** -0.5

    def one_block(args):
        q_blk, k_blk, v_blk, bid = args
        s_loc = jnp.einsum('bqkgd,bskd->bkgqs', q_blk, k_blk).astype(jnp.float32) * scale
        s_ctx = jnp.einsum('bqkgd,bskd->bkgqs', q_blk, kc).astype(jnp.float32) * scale
        qpos = bid * BLOCK + jnp.arange(BLOCK, dtype=jnp.int32)
        kpos = (bid - 1) * BLOCK + jnp.arange(3 * BLOCK, dtype=jnp.int32)
        valid = (jnp.abs(kpos[None, :] - qpos[:, None]) <= WINDOW) & (kpos[None, :] >= 0) & (kpos[None, :] < s_len)
        s_loc = jnp.where(valid[None, None, None], s_loc, NEG)
        p = softmax_with_sink(jnp.concatenate([s_ctx, s_loc], axis=-1), sink).astype(v_blk.dtype)
        n_ctx = kc.shape[1]
        o = jnp.einsum('bkgqs,bskd->bqkgd', p[..., :n_ctx], vc) + \
            jnp.einsum('bkgqs,bskd->bqkgd', p[..., n_ctx:], v_blk)
        return o

    o = lax.map(one_block, (qb, kb, vb, bids))
    return o.transpose(1, 0, 2, 3, 4, 5).reshape(b, s_len, Q_W)


def short_conv(u, w, bias):
    up = jnp.pad(u, ((0, 0), (1, 1), (0, 0)))
    return up[:, :-2] * w[0] + up[:, 1:-1] * w[1] + up[:, 2:] * w[2] + bias


def merge_branches(attn, cb, cc, cx, ga, gc, conv_w, conv_b, w_attn_out, w_conv_out, w_o):
    attn_branch = attn @ w_attn_out
    conv_branch = (cb * short_conv(cc * cx, conv_w, conv_b)) @ w_conv_out
    m = jax.nn.sigmoid(ga) * attn_branch + jax.nn.sigmoid(gc) * conv_branch
    return m @ w_o


def swiglu(h, w_in, w_out):
    gate, up = jnp.split(h @ w_in, 2, axis=-1)
    return (jax.nn.silu(gate) * up) @ w_out


def heads(t, n):
    return t.reshape(t.shape[0], t.shape[1], n, HEAD_DIM)


def setup_inputs(seed: int = 0) -> dict:
    key = jax.random.key(seed)
    ks = jax.random.split(key, 20)
    f32 = jnp.float32

    def nrm(k, shape, scale):
        return jax.random.normal(k, shape, f32) * scale

    return {
        "x": nrm(ks[0], (BATCH, SEQ, D_MODEL), 1.0),
        "c": nrm(ks[1], (BATCH, D_MODEL), 1.0),
        "ctx": nrm(ks[2], (BATCH, CTX_LEN, D_MODEL), 1.0),
        "c_ctx": nrm(ks[3], (D_MODEL,), 1.0),
        "ada_w": nrm(ks[4], (DEPTH, D_MODEL, 6 * D_MODEL), 0.5 * D_MODEL ** -0.5),
        "ada_b": nrm(ks[5], (DEPTH, 6 * D_MODEL), 0.01),
        "norm1_g": 1.0 + nrm(ks[6], (DEPTH, D_MODEL), 0.01),
        "norm2_g": 1.0 + nrm(ks[7], (DEPTH, D_MODEL), 0.01),
        "w_in": nrm(ks[8], (DEPTH, D_MODEL, IN_COLS), D_MODEL ** -0.5),
        "conv_w": nrm(ks[9], (DEPTH, CONV_WIDTH, D_CONV), CONV_WIDTH ** -0.5),
        "conv_b": nrm(ks[10], (DEPTH, D_CONV), 0.01),
        "sink": nrm(ks[11], (DEPTH, N_HEADS), 0.5),
        "w_attn_out": nrm(ks[12], (DEPTH, Q_W, D_MODEL), Q_W ** -0.5),
        "w_conv_out": nrm(ks[13], (DEPTH, D_CONV, D_MODEL), D_CONV ** -0.5),
        "w_o": nrm(ks[14], (DEPTH, D_MODEL, D_MODEL), D_MODEL ** -0.5),
        "w_ffn_in": nrm(ks[15], (DEPTH, D_MODEL, 2 * D_FF), D_MODEL ** -0.5),
        "w_ffn_out": nrm(ks[16], (DEPTH, D_FF, D_MODEL), D_FF ** -0.5),
        "final_g": 1.0 + nrm(ks[17], (D_MODEL,), 0.01),
    }


def reference(x, c, ctx, c_ctx, ada_w, ada_b, norm1_g, norm2_g, w_in, conv_w, conv_b, sink,
              w_attn_out, w_conv_out, w_o, w_ffn_in, w_ffn_out, final_g):
    n_lat = x.shape[1]
    ROWS = n_lat // GRID_W
    grid_r, grid_c = jnp.meshgrid(jnp.arange(ROWS, dtype=jnp.int32), jnp.arange(GRID_W, dtype=jnp.int32), indexing='ij')
    row = grid_r.reshape(-1).astype(jnp.float32)
    col = grid_c.reshape(-1).astype(jnp.float32)

    xc = ctx
    for l in range(DEPTH):
        last = l == DEPTH - 1
        sh1, sc1, g1, sh2, sc2, g2 = [t[:, None, :] for t in ada_split(c, ada_w[l], ada_b[l])]
        csh1, csc1, cg1, csh2, csc2, cg2 = ada_split(c_ctx, ada_w[l], ada_b[l])

        h = modulate(x, norm1_g[l], sh1, sc1)
        q, k, v, cb, cc, cx, ga, gc = jnp.split(h @ w_in[l], IN_OFFSETS, axis=-1)
        q = axial_rope(heads(q, N_HEADS), row, col)
        k = axial_rope(heads(k, N_KV_HEADS), row, col)
        v = heads(v, N_KV_HEADS)

        hc = modulate(xc, norm1_g[l], csh1, csc1)
        if last:
            kc_, vc_ = jnp.split(hc @ w_in[l][:, Q_W:Q_W + 2 * KV_W], 2, axis=-1)
        else:
            qc_, kc_, vc_, cbc, ccc, cxc, gac, gcc = jnp.split(hc @ w_in[l], IN_OFFSETS, axis=-1)
        kc = heads(kc_, N_KV_HEADS)
        vc = heads(vc_, N_KV_HEADS)

        attn = latent_window_attention(q, k, v, kc, vc, sink[l])
        x = x + g1 * merge_branches(attn, cb, cc, cx, ga, gc, conv_w[l], conv_b[l],
                                    w_attn_out[l], w_conv_out[l], w_o[l])

        if not last:
            attn_c = context_attention(heads(qc_, N_HEADS), kc, vc, sink[l])
            xc = xc + cg1 * merge_branches(attn_c, cbc, ccc, cxc, gac, gcc, conv_w[l], conv_b[l],
                                           w_attn_out[l], w_conv_out[l], w_o[l])
            xc = xc + cg2 * swiglu(modulate(xc, norm2_g[l], csh2, csc2), w_ffn_in[l], w_ffn_out[l])

        x = x + g2 * swiglu(modulate(x, norm2_g[l], sh2, sc2), w_ffn_in[l], w_ffn_out[l])

    return rmsnorm(x, final_g)
```

```cpp
#include <hip/hip_runtime.h>
#include <hip/hip_cooperative_groups.h>
#include <cstdio>
#include <cstdint>
namespace cg = cooperative_groups;

#ifndef REP_P0
#define REP_P0 1
#endif
#ifndef REP_ATT
#define REP_ATT 1
#endif
#ifndef REP_NORM
#define REP_NORM 1
#endif
#ifndef REP_INPROJ
#define REP_INPROJ 1
#endif
#ifndef REP_MERGE
#define REP_MERGE 1
#endif
#ifndef REP_FFN1
#define REP_FFN1 1
#endif
#ifndef REP_SYNC
#define REP_SYNC 1
#endif
#ifndef MK_MULTI
#define MK_MULTI 0
#endif

#define LAS __attribute__((address_space(3)))
typedef unsigned short bf16_t;
typedef short bf16x8 __attribute__((ext_vector_type(8)));
typedef short s16x4 __attribute__((ext_vector_type(4)));
typedef float f32x4 __attribute__((ext_vector_type(4)));
typedef float f32x16 __attribute__((ext_vector_type(16)));
typedef unsigned u32x4 __attribute__((ext_vector_type(4)));
typedef unsigned u32x2 __attribute__((ext_vector_type(2)));

constexpr int D = 2048, BATCH = 2, SEQ = 8192, ML = BATCH * SEQ, CTXL = 256, MC = BATCH * CTXL, MT = ML + MC;
constexpr int NKV = 4, HD = 64, DFF = 5632, NIN = 12800, NF1 = 2 * DFF, DEPTH = 2;
constexpr int OFF_CC = 4608, OFF_CX = 6656, OFF_GA = 8704, OFF_GC = 10752;
constexpr float EPS = 1e-6f;
constexpr float QSCALE = 0.125f * 1.4426950408889634f;
constexpr float LOG2E = 1.4426950408889634f;

constexpr size_t MiB = 1u << 20;
constexpr size_t WS_ADA = 1 * MiB;
constexpr size_t WS_ROPE = 1 * MiB + 512 * 1024;
constexpr size_t WS_XC = 2 * MiB;
constexpr size_t WS_W = 8 * MiB;
constexpr size_t W_LAYER = 140 * MiB, W_IN = 0, W_A = 50 * MiB, W_C = 58 * MiB, W_O = 66 * MiB, W_F1 = 74 * MiB, W_F2 = 118 * MiB;
constexpr size_t WS_H = 288 * MiB;
constexpr size_t WS_Q = 354 * MiB;
constexpr size_t WS_CB = 420 * MiB;
constexpr size_t WS_U = 486 * MiB;
constexpr size_t WS_RHO = 552 * MiB;
constexpr size_t WS_SC = 618 * MiB;
constexpr size_t WS_K = 684 * MiB;
constexpr size_t WS_V = 693 * MiB;
constexpr size_t WS_HID = WS_Q;
constexpr size_t WS_PART = 702 * MiB;
constexpr size_t WS_END = 746 * MiB;

__device__ __forceinline__ unsigned cvt_pk_bf16(float lo, float hi) { unsigned r; asm volatile("v_cvt_pk_bf16_f32 %0, %1, %2" : "=v"(r) : "v"(lo), "v"(hi)); return r; }
__device__ __forceinline__ float bf_lo(unsigned u) { return __uint_as_float(u << 16); }
__device__ __forceinline__ float bf_hi(unsigned u) { return __uint_as_float(u & 0xffff0000u); }
__device__ __forceinline__ float xor_lane(float v, int lane, int mask) { return __int_as_float(__builtin_amdgcn_ds_bpermute((lane ^ mask) << 2, __float_as_int(v))); }
__device__ __forceinline__ float wave_sum(float v, int lane) {
#pragma unroll
    for (int o = 1; o < 64; o <<= 1) v += xor_lane(v, lane, o);
    return v;
}
__device__ __forceinline__ float fast_sigmoid(float x) { return __builtin_amdgcn_rcpf(1.0f + __builtin_amdgcn_exp2f(-x * LOG2E)); }

namespace pg8 {
constexpr int BM = 256, BK = 64, HALF = 128, HTB = HALF * BK * 2, STAGE_BYTES = 8 * HTB, NXCD = 8, WGM = 8;
__device__ __forceinline__ int lds_byte(int r, int c) { const int st = (r >> 4) * 2 + (c >> 5), rr = r & 15, cc = c & 31, ob = rr * 64 + cc * 2; return st * 1024 + (ob ^ (((ob >> 9) & 1) << 5)); }
__device__ __forceinline__ void stage_rc(int b, int& R, int& C) { const int st = b / 1024, sb = b % 1024, swz = sb ^ (((sb >> 9) & 1) << 5); R = (st >> 1) * 16 + swz / 64; C = (st & 1) * 32 + (swz % 64) / 2; }
__device__ __forceinline__ int perm32(int rho) { const int n = rho >> 4, i = rho & 15; return 8 * (i >> 2) + 4 * n + (i & 3); }

struct Unit { int pm, pn, src, nt, koff; };

struct Sched {
    int nM, nN, nwg, G, c, mode, extra, ks, ntfull;
    const char *A0, *A1, *B0, *B1; size_t tstep;
    __device__ __forceinline__ bool next(int i, Unit& u) const {
        const int ti = mode == 1 ? (i >> 1) : i; u.src = mode == 1 ? (i & 1) : 0; u.nt = ntfull; u.koff = 0;
        const long L = (long)ti * G + c;
        if (L >= nwg + extra) return false;
        if (L >= nwg) { const int e = (int)L - nwg;
            if (mode == 1) { if (i & 1) return false; const int tile = e >> 1; u.pm = 64 + (tile >> 3); u.pn = tile & 7; u.src = 4 + (e & 1); }
            else if (mode == 2) { const int tile = e / ks, kc = e % ks; u.pm = 64 + (tile >> 3); u.pn = tile & 7; u.src = 2 + kc; u.nt = 8; u.koff = kc * 1024; }
            else { u.pm = 64 + (e >> 1); u.pn = 8 + (e & 1); }
            return true; }
        int wgid = (int)L; { const int q = nwg / NXCD, r = nwg % NXCD, xcd = wgid % NXCD, off = wgid / NXCD; wgid = (xcd < r ? xcd * (q + 1) : r * (q + 1) + (xcd - r) * q) + off; }
        const int nig = WGM * nN, gid = wgid / nig, fm = gid * WGM, gsz = (nM - fm) < WGM ? (nM - fm) : WGM;
        u.pm = fm + ((wgid % nig) % gsz); u.pn = (wgid % nig) / gsz; return true;
    }
    __device__ __forceinline__ const char* a_base(const Unit& u) const { return ((u.src == 1 || u.src == 5) ? A1 : A0) + (size_t)u.pm * tstep + u.koff; }
    __device__ __forceinline__ const char* b_base(const Unit& u) const { return ((u.src == 1 || u.src == 5) ? B1 : B0) + (size_t)u.pn * tstep + u.koff; }
};

template <int NT, class Epi>
__device__ __forceinline__ void gemm_phase(LAS unsigned char* lds, const int K, const Sched& S, const Epi& E) {
    int tid = threadIdx.x; asm volatile("" : "+v"(tid));
    const int wid = __builtin_amdgcn_readfirstlane(tid >> 6), lane = tid & 63, wr = wid >> 2, wc = wid & 3, fr = lane & 15, fq = lane >> 4;
    unsigned voffA[2], voffB[2];
#pragma unroll
    for (int i = 0; i < 2; ++i) { int R, C; stage_rc(tid * 16 + i * 8192, R, C); const int Rb = (R & ~31) + perm32(R & 31);
        voffA[i] = (unsigned)(R * K + C) * 2u; voffB[i] = (unsigned)(Rb * K + C) * 2u; }
    const size_t kstep = (size_t)(BK * 2);
    const size_t hstep = (size_t)HALF * K * 2;
    const unsigned ldsw = (unsigned)wid * 1024u;
    const int aoff = lds_byte(wr * 64 + fr, fq * 8), boff = lds_byte(wc * 32 + fr, fq * 8);
    const unsigned ldsa = (unsigned)(size_t)lds + (unsigned)aoff, ldsb = (unsigned)(size_t)lds + (unsigned)boff;
#define PG8_SA(b, h) (((b) * 2 + (h)) * HTB)
#define PG8_SB(b, h) ((4 + (b) * 2 + (h)) * HTB)
#define PG8_STAGE(bufoff, gbase, voff) do { _Pragma("unroll") for (int _i = 0; _i < 2; ++_i) \
        __builtin_amdgcn_global_load_lds((const unsigned*)((const char*)(gbase) + (voff)[_i]), (LAS unsigned*)(lds + (bufoff) + ldsw + _i * 8192), 16, 0, 0); } while (0)
#define PG8_DSR(dst, addr, off) asm volatile("ds_read_b128 %0, %1 offset:%2" : "=v"(dst) : "v"(addr), "n"(off))
#define PG8_LDA(dst, b, h) do { const unsigned _a = ldsa + PG8_SA(b, h); _Pragma("unroll") for (int m = 0; m < 4; ++m) _Pragma("unroll") for (int k = 0; k < 2; ++k) PG8_DSR(dst[m][k], _a, m * 2048 + k * 1024); } while (0)
#define PG8_LDB(dst, b, h) do { const unsigned _b = ldsb + PG8_SB(b, h); _Pragma("unroll") for (int n = 0; n < 2; ++n) _Pragma("unroll") for (int k = 0; k < 2; ++k) PG8_DSR(dst[n][k], _b, n * 2048 + k * 1024); } while (0)
#define PG8_MMA(ai, bj, At, Bt) do { __builtin_amdgcn_s_setprio(1); _Pragma("unroll") for (int m = 0; m < 4; ++m) _Pragma("unroll") for (int n = 0; n < 2; ++n) _Pragma("unroll") for (int k = 0; k < 2; ++k) \
        acc[ai][bj][m][n] = __builtin_amdgcn_mfma_f32_16x16x32_bf16(Bt[n][k], At[m][k], acc[ai][bj][m][n], 0, 0, 0); __builtin_amdgcn_s_setprio(0); } while (0)
#define PG8_WAIT_V(n) asm volatile("s_waitcnt vmcnt(" #n ")" ::: "memory")
#define PG8_WAIT_L(n) asm volatile("s_waitcnt lgkmcnt(" #n ")" ::: "memory")
#define PG8_BAR __builtin_amdgcn_s_barrier()
#define PG8_SCHED __builtin_amdgcn_sched_barrier(0)
    Unit cur, nxt; int ui = 0;
    if (!S.next(0, cur)) return;
    __builtin_amdgcn_s_waitcnt(0);
    f32x4 acc[2][2][4][2];
#pragma unroll
    for (int a = 0; a < 2; ++a)
#pragma unroll
        for (int b = 0; b < 2; ++b)
#pragma unroll
            for (int m = 0; m < 4; ++m)
#pragma unroll
                for (int n = 0; n < 2; ++n) acc[a][b][m][n] = (f32x4){0.f, 0.f, 0.f, 0.f};
    bf16x8 At[4][2], B0[2][2], B1[2][2];
    const char* cA = S.a_base(cur); const char* cB = S.b_base(cur);
    PG8_STAGE(PG8_SB(0, 0), cB, voffB); PG8_STAGE(PG8_SB(0, 1), cB + hstep, voffB); PG8_STAGE(PG8_SA(0, 0), cA, voffA); PG8_STAGE(PG8_SA(0, 1), cA + hstep, voffA);
    if (wr == 1) PG8_BAR;
    PG8_WAIT_V(2); PG8_BAR;
    PG8_STAGE(PG8_SB(1, 0), cB + kstep, voffB); PG8_STAGE(PG8_SA(1, 0), cA + kstep, voffA); PG8_STAGE(PG8_SB(1, 1), cB + hstep + kstep, voffB);
    PG8_WAIT_V(6); PG8_BAR;
    for (;;) {
        const bool has_next = S.next(ui + 1, nxt);
        const char* nA = has_next ? S.a_base(nxt) : cA; const char* nB = has_next ? S.b_base(nxt) : cB;
        constexpr int nt = NT;
        for (int t = 0; t < nt; t += 2) {
            const bool last = (t == nt - 2);
            asm volatile(".p2align 4" ::: "memory");
            const char* a1 = cA + (size_t)(t + 1) * kstep;
            const char* a2 = last ? nA : cA + (size_t)(t + 2) * kstep; const char* b2 = last ? nB : cB + (size_t)(t + 2) * kstep;
            const char* a3 = a2 + kstep; const char* b3 = b2 + kstep;
            PG8_LDB(B0, 0, 0); PG8_LDB(B1, 0, 1); PG8_SCHED; PG8_LDA(At, 0, 0); PG8_STAGE(PG8_SA(1, 1), a1 + hstep, voffA);
            PG8_WAIT_V(8); PG8_WAIT_L(0); PG8_BAR; PG8_MMA(0, 0, At, B0); PG8_MMA(0, 1, At, B1); PG8_BAR; PG8_SCHED;
            PG8_LDA(At, 0, 1); PG8_STAGE(PG8_SB(0, 0), b2, voffB); PG8_STAGE(PG8_SB(0, 1), b2 + hstep, voffB); PG8_STAGE(PG8_SA(0, 0), a2, voffA);
            PG8_WAIT_V(8); PG8_WAIT_L(0); PG8_BAR; PG8_MMA(1, 0, At, B0); PG8_MMA(1, 1, At, B1); PG8_BAR; PG8_SCHED;
            PG8_LDB(B0, 1, 0); PG8_LDB(B1, 1, 1); PG8_SCHED; PG8_LDA(At, 1, 0); PG8_STAGE(PG8_SA(0, 1), a2 + hstep, voffA);
            PG8_WAIT_V(8); PG8_WAIT_L(0); PG8_BAR; PG8_MMA(0, 0, At, B0); PG8_MMA(0, 1, At, B1); PG8_BAR; PG8_SCHED;
            PG8_LDA(At, 1, 1); PG8_STAGE(PG8_SB(1, 0), b3, voffB); PG8_STAGE(PG8_SB(1, 1), b3 + hstep, voffB); PG8_STAGE(PG8_SA(1, 0), a3, voffA);
            PG8_WAIT_V(8); PG8_WAIT_L(0); PG8_BAR; PG8_MMA(1, 0, At, B0); PG8_MMA(1, 1, At, B1); PG8_BAR; PG8_SCHED;
        }
        if (wr == 0) PG8_BAR;
        const bool keep = E(acc, cur, wr, wc, fr, fq);
        __builtin_amdgcn_s_waitcnt(0x0F70);
        if (!has_next) break;
        if (!keep) {
#pragma unroll
            for (int a = 0; a < 2; ++a)
#pragma unroll
                for (int b = 0; b < 2; ++b)
#pragma unroll
                    for (int m = 0; m < 4; ++m)
#pragma unroll
                        for (int n = 0; n < 2; ++n) acc[a][b][m][n] = (f32x4){0.f, 0.f, 0.f, 0.f};
        }
        cur = nxt; cA = nA; cB = nB; ++ui;
        if (wr == 1) PG8_BAR;
    }
    PG8_WAIT_V(0);
    PG8_BAR;
#undef PG8_SA
#undef PG8_SB
#undef PG8_STAGE
#undef PG8_LDA
#undef PG8_DSR
#undef PG8_LDB
#undef PG8_MMA
#undef PG8_WAIT_V
#undef PG8_WAIT_L
#undef PG8_BAR
#undef PG8_SCHED
}
}
using pg8::Unit;

__device__ __forceinline__ u32x4 pack8(const f32x4 a, const f32x4 b) { u32x4 w; w.x = cvt_pk_bf16(a[0], a[1]); w.y = cvt_pk_bf16(a[2], a[3]); w.z = cvt_pk_bf16(b[0], b[1]); w.w = cvt_pk_bf16(b[2], b[3]); return w; }

struct EpiInProj {
    bf16_t *Q, *Kb, *Vb, *CB, *U, *RHO, *SC; const float* rope;
    __device__ __forceinline__ bool operator()(f32x4 (&acc)[2][2][4][2], const Unit& u, int wr, int wc, int fr, int fq) const {
        const int row0 = u.pm * 256 + wr * 64 + fr, pn = u.pn, cw = wc * 32 + fq * 8;
        if (pn <= 8) {
            bf16_t* dst = pn < 8 ? Q : Kb; const int ld = pn < 8 ? D : 256; const int cbase = pn < 8 ? pn * 256 : 0; const float sc = pn < 8 ? QSCALE : 1.0f;
            const bool lat = u.pm < 64;
#pragma unroll
            for (int ai = 0; ai < 2; ++ai) {
                f32x4 cvv[4], svv[4];
#pragma unroll
                for (int m = 0; m < 4; ++m) {
                    const int row = row0 + ai * 128 + m * 16; const int t = row & (SEQ - 1);
                    const int pos = (wc & 1) ? (t & 63) : (t >> 6);
                    cvv[m] = (f32x4){1.f, 1.f, 1.f, 1.f}; svv[m] = (f32x4){0.f, 0.f, 0.f, 0.f};
                    if (lat) { cvv[m] = *(const f32x4*)(rope + pos * 16 + 4 * fq); svv[m] = *(const f32x4*)(rope + 2048 + pos * 16 + 4 * fq); }
                }
                __builtin_amdgcn_sched_barrier(0);
#pragma unroll
                for (int m = 0; m < 4; ++m) {
                    const int row = row0 + ai * 128 + m * 16; const f32x4 cv = cvv[m], sv = svv[m];
#pragma unroll
                    for (int bj = 0; bj < 2; ++bj) {
                        const f32x4 x1 = acc[ai][bj][m][0], x2 = acc[ai][bj][m][1];
                        const f32x4 y1 = (x1 * cv - x2 * sv) * sc, y2 = (x2 * cv + x1 * sv) * sc;
                        *(u32x4*)(dst + (size_t)row * ld + cbase + bj * 128 + cw) = pack8(y1, y2);
                    }
                }
                __builtin_amdgcn_sched_barrier(0);
            }
        } else if (pn <= 17) {
            bf16_t* dst = pn == 9 ? Vb : CB; const int ld = pn == 9 ? 256 : D; const int cbase = pn == 9 ? 0 : (pn - 10) * 256;
#pragma unroll
            for (int ai = 0; ai < 2; ++ai)
#pragma unroll
                for (int m = 0; m < 4; ++m) {
                    const int row = row0 + ai * 128 + m * 16;
#pragma unroll
                    for (int bj = 0; bj < 2; ++bj) *(u32x4*)(dst + (size_t)row * ld + cbase + bj * 128 + cw) = pack8(acc[ai][bj][m][0], acc[ai][bj][m][1]);
                }
        } else if (pn <= 33) {
            const int cbase = (pn - 18) * 128 + cw;
#pragma unroll
            for (int ai = 0; ai < 2; ++ai)
#pragma unroll
                for (int m = 0; m < 4; ++m) {
                    const int row = row0 + ai * 128 + m * 16;
                    *(u32x4*)(U + (size_t)row * D + cbase) = pack8(acc[ai][0][m][0] * acc[ai][1][m][0], acc[ai][0][m][1] * acc[ai][1][m][1]);
                }
        } else {
            const int cbase = (pn - 34) * 128 + cw;
#pragma unroll
            for (int ai = 0; ai < 2; ++ai)
#pragma unroll
                for (int m = 0; m < 4; ++m) {
                    const int row = row0 + ai * 128 + m * 16;
                    f32x4 r0, r1, s0, s1;
#pragma unroll
                    for (int j = 0; j < 4; ++j) {
                        const float ea0 = __builtin_amdgcn_exp2f(-acc[ai][0][m][0][j] * LOG2E), ea1 = __builtin_amdgcn_exp2f(-acc[ai][0][m][1][j] * LOG2E);
                        const float ec0 = __builtin_amdgcn_exp2f(-acc[ai][1][m][0][j] * LOG2E), ec1 = __builtin_amdgcn_exp2f(-acc[ai][1][m][1][j] * LOG2E);
                        s0[j] = __builtin_amdgcn_rcpf(1.0f + ec0); s1[j] = __builtin_amdgcn_rcpf(1.0f + ec1);
                        r0[j] = (1.0f + ec0) * __builtin_amdgcn_rcpf(1.0f + ea0); r1[j] = (1.0f + ec1) * __builtin_amdgcn_rcpf(1.0f + ea1);
                    }
                    *(u32x4*)(RHO + (size_t)row * D + cbase) = pack8(r0, r1);
                    *(u32x4*)(SC + (size_t)row * D + cbase) = pack8(s0, s1);
                }
        }
        return false;
    }
};

struct EpiMerge {
    const bf16_t *RHO, *SC; bf16_t* Mo; float* part;
    __device__ __forceinline__ bool operator()(f32x4 (&acc)[2][2][4][2], const Unit& u, int wr, int wc, int fr, int fq) const {
        const int row0 = u.pm * 256 + wr * 64 + fr, c0 = u.pn * 256 + wc * 32 + fq * 8;
        const bf16_t* G = u.src == 0 ? RHO : SC;
        float* pd = part + (size_t)u.src * MC * D - (size_t)ML * D;
#pragma unroll
        for (int b4 = 0; b4 < 4; ++b4) {
            const int ai = b4 >> 1, mh = (b4 & 1) * 2;
            u32x4 gq[2][2];
#pragma unroll
            for (int mm = 0; mm < 2; ++mm)
#pragma unroll
                for (int bj = 0; bj < 2; ++bj) { const size_t ro = (size_t)(row0 + ai * 128 + (mh + mm) * 16) * D + c0 + bj * 128;
                    gq[mm][bj] = *(const u32x4*)(G + ro); }
            __builtin_amdgcn_sched_barrier(0);
#pragma unroll
            for (int mm = 0; mm < 2; ++mm)
#pragma unroll
                for (int bj = 0; bj < 2; ++bj) { const size_t ro = (size_t)(row0 + ai * 128 + (mh + mm) * 16) * D + c0 + bj * 128; const int m = mh + mm;
                    const u32x4 g = gq[mm][bj];
                    f32x4 g0 = (f32x4){bf_lo(g.x), bf_hi(g.x), bf_lo(g.y), bf_hi(g.y)}, g1 = (f32x4){bf_lo(g.z), bf_hi(g.z), bf_lo(g.w), bf_hi(g.w)};
                    if (u.src == 4) { const u32x4 r = *(const u32x4*)(RHO + ro);
                        g0 *= (f32x4){bf_lo(r.x), bf_hi(r.x), bf_lo(r.y), bf_hi(r.y)}; g1 *= (f32x4){bf_lo(r.z), bf_hi(r.z), bf_lo(r.w), bf_hi(r.w)}; }
                    acc[ai][bj][m][0] *= g0; acc[ai][bj][m][1] *= g1;
                    if (u.src == 1) *(u32x4*)(Mo + ro) = pack8(acc[ai][bj][m][0], acc[ai][bj][m][1]);
                    if (u.src >= 4) { *(f32x4*)(pd + ro) = acc[ai][bj][m][0]; *(f32x4*)(pd + ro + 4) = acc[ai][bj][m][1]; }
                }
            __builtin_amdgcn_sched_barrier(0);
        }
        return u.src == 0;
    }
};

struct EpiResid {
    const float *xl_src, *xc_src; float *xl_dst, *xc_dst; const float* gate; float* part;
    __device__ __forceinline__ bool operator()(f32x4 (&acc)[2][2][4][2], const Unit& u, int wr, int wc, int fr, int fq) const {
        if (u.src >= 2) {
            float* pd = part + (size_t)(u.src - 2) * MC * D + (size_t)((u.pm - 64) * 256 + wr * 64 + fr) * D + u.pn * 256 + wc * 32 + fq * 8;
#pragma unroll
            for (int ai = 0; ai < 2; ++ai)
#pragma unroll
                for (int m = 0; m < 4; ++m)
#pragma unroll
                    for (int bj = 0; bj < 2; ++bj) { float* q = pd + (size_t)(ai * 128 + m * 16) * D + bj * 128; *(f32x4*)q = acc[ai][bj][m][0]; *(f32x4*)(q + 4) = acc[ai][bj][m][1]; }
            return false;
        }
        const bool lat = u.pm < 64; const int vec = lat ? (u.pm >> 5) : 2;
        const float* xs = lat ? xl_src : xc_src - (size_t)ML * D; float* xd = lat ? xl_dst : xc_dst - (size_t)ML * D;
        const int row0 = u.pm * 256 + wr * 64 + fr, c0 = u.pn * 256 + wc * 32 + fq * 8;
        const float* gp = gate + vec * 12288 + c0;
        f32x4 gv[2][2];
#pragma unroll
        for (int bj = 0; bj < 2; ++bj) { gv[bj][0] = *(const f32x4*)(gp + bj * 128); gv[bj][1] = *(const f32x4*)(gp + bj * 128 + 4); }
#pragma unroll
        for (int b4 = 0; b4 < 4; ++b4) {
            const int ai = b4 >> 1, mh = (b4 & 1) * 2;
            f32x4 xv[2][2][2];
#pragma unroll
            for (int mm = 0; mm < 2; ++mm)
#pragma unroll
                for (int bj = 0; bj < 2; ++bj) { const float* p = xs + (size_t)(row0 + ai * 128 + (mh + mm) * 16) * D + c0 + bj * 128; xv[mm][bj][0] = *(const f32x4*)p; xv[mm][bj][1] = *(const f32x4*)(p + 4); }
            __builtin_amdgcn_sched_barrier(0);
#pragma unroll
            for (int mm = 0; mm < 2; ++mm)
#pragma unroll
                for (int bj = 0; bj < 2; ++bj) { float* q = xd + (size_t)(row0 + ai * 128 + (mh + mm) * 16) * D + c0 + bj * 128;
                    *(f32x4*)q = xv[mm][bj][0] + gv[bj][0] * acc[ai][bj][mh + mm][0]; *(f32x4*)(q + 4) = xv[mm][bj][1] + gv[bj][1] * acc[ai][bj][mh + mm][1]; }
            __builtin_amdgcn_sched_barrier(0);
        }
        return false;
    }
};

struct EpiSwiglu {
    bf16_t* HID;
    __device__ __forceinline__ bool operator()(f32x4 (&acc)[2][2][4][2], const Unit& u, int wr, int wc, int fr, int fq) const {
        const int row0 = u.pm * 256 + wr * 64 + fr, c0 = u.pn * 128 + wc * 32 + fq * 8;
#pragma unroll
        for (int ai = 0; ai < 2; ++ai)
#pragma unroll
            for (int m = 0; m < 4; ++m) {
                f32x4 h0, h1;
#pragma unroll
                for (int j = 0; j < 4; ++j) {
                    const float g0 = acc[ai][0][m][0][j], g1 = acc[ai][0][m][1][j];
                    h0[j] = g0 * fast_sigmoid(g0) * acc[ai][1][m][0][j]; h1[j] = g1 * fast_sigmoid(g1) * acc[ai][1][m][1][j];
                }
                *(u32x4*)(HID + (size_t)(row0 + ai * 128 + m * 16) * DFF + c0) = pack8(h0, h1);
            }
        return false;
    }
};

struct Args {
    const float* in[18]; float* out; unsigned char* ws; int ph_lo, ph_hi;
};

__device__ __forceinline__ int src_group_base(int kind, int n0, bool& ropeperm) {
    ropeperm = false;
    if (kind == 0) return n0;
    const int pn = n0 >> 8, off = n0 & 255;
    if (kind == 1) {
        if (pn <= 8) { ropeperm = true; return n0; }
        if (pn <= 17) return n0;
        if (pn <= 33) { const int j = pn - 18; return off < 128 ? OFF_CC + 128 * j + off : OFF_CX + 128 * j + off - 128; }
        const int j = pn - 34; return off < 128 ? OFF_GA + 128 * j + off : OFF_GC + 128 * j + off - 128;
    }
    return off < 128 ? 128 * pn + off : DFF + 128 * pn + off - 128;
}
__device__ __forceinline__ void transpose_item(const float* W, int K, int N, int NP, int kind, bf16_t* WT, LAS float* scr, int item, int lane) {
    const int nblk = NP / 32, kb = item / nblk, nb = item % nblk, k0 = 64 * kb, n0 = 32 * nb;
    bool rp; const int sb = src_group_base(kind, n0, rp);
    const int p = lane & 31; const int so = rp ? (4 * (p >> 3) + (p & 3) + 16 * ((p >> 2) & 1)) : p;
#pragma unroll 8
    for (int i = 0; i < 32; ++i) { const int kk = 2 * i + (lane >> 5); scr[kk * 33 + p] = W[(size_t)(k0 + kk) * N + sb + so]; }
    asm volatile("s_waitcnt lgkmcnt(0)" ::: "memory");
    const int c = lane & 7;
#pragma unroll
    for (int j = 0; j < 4; ++j) { const int n = (lane >> 3) + 8 * j; const LAS float* s = scr + (8 * c) * 33 + n;
        u32x4 o; o.x = cvt_pk_bf16(s[0 * 33], s[1 * 33]); o.y = cvt_pk_bf16(s[2 * 33], s[3 * 33]); o.z = cvt_pk_bf16(s[4 * 33], s[5 * 33]); o.w = cvt_pk_bf16(s[6 * 33], s[7 * 33]);
        *(u32x4*)(WT + (size_t)(n0 + n) * K + k0 + 8 * c) = o; }
    asm volatile("s_waitcnt lgkmcnt(0)" ::: "memory");
}

__device__ __forceinline__ void sincos_f32(float ang, float& sn, float& cs) {
    const float k = rintf(ang * 0.15915494309189535f);
    float r = fmaf(-k, 6.28125f, ang); r = fmaf(-k, 1.935307179586232e-3f, r);
    const float r2 = r * r;
    float ps = -1.0f / 51090942171709440000.0f;
    ps = fmaf(ps, r2, 1.0f / 121645100408832000.0f); ps = fmaf(ps, r2, -1.0f / 355687428096000.0f); ps = fmaf(ps, r2, 1.0f / 1307674368000.0f);
    ps = fmaf(ps, r2, -1.0f / 6227020800.0f); ps = fmaf(ps, r2, 1.0f / 39916800.0f); ps = fmaf(ps, r2, -1.0f / 362880.0f); ps = fmaf(ps, r2, 1.0f / 5040.0f);
    ps = fmaf(ps, r2, -1.0f / 120.0f); ps = fmaf(ps, r2, 1.0f / 6.0f); sn = fmaf(-r * r2, ps, r);
    float pc = 1.0f / 2432902008176640000.0f;
    pc = fmaf(pc, r2, -1.0f / 6402373705728000.0f); pc = fmaf(pc, r2, 1.0f / 20922789888000.0f); pc = fmaf(pc, r2, -1.0f / 87178291200.0f); pc = fmaf(pc, r2, 1.0f / 479001600.0f);
    pc = fmaf(pc, r2, -1.0f / 3628800.0f); pc = fmaf(pc, r2, 1.0f / 40320.0f); pc = fmaf(pc, r2, -1.0f / 720.0f); pc = fmaf(pc, r2, 1.0f / 24.0f); pc = fmaf(pc, r2, -0.5f);
    cs = fmaf(pc, r2, 1.0f);
}

constexpr int KSTR = 144, VSTR = 192;
constexpr int ATT_K = 0, ATT_V = 2 * 64 * KSTR;
__device__ __forceinline__ s16x4 vtr(const LAS unsigned char* p) { return __builtin_bit_cast(s16x4, __builtin_amdgcn_ds_read_tr16_b64_v4i16((LAS s16x4*)p)); }

__device__ __forceinline__ void attn_unit(LAS unsigned char* lds, const bf16_t* Q, const bf16_t* Kb, const bf16_t* Vb, bf16_t* O, const float* sink,
                                          int qrow0, int kvh, int crow0, int lrow0, int jlo, int jhi, int qpos0) {
    int tid = threadIdx.x; asm volatile("" : "+v"(tid));
    const int wid = __builtin_amdgcn_readfirstlane(tid >> 6), lane = tid & 63, l31 = lane & 31, h = lane >> 5;
    const int head = kvh * 8 + wid;
    const int ntile = 4 + (jhi - jlo + 1);
    bf16x8 Qf[2][4];
#pragma unroll
    for (int qs = 0; qs < 2; ++qs)
#pragma unroll
        for (int ks = 0; ks < 4; ++ks) Qf[qs][ks] = *(const bf16x8*)(Q + (size_t)(qrow0 + 32 * qs + l31) * D + head * 64 + 16 * ks + 8 * h);
    const float sk = sink[head] * LOG2E;
    float mrow[2] = {sk, sk}, lsum[2] = {h == 0 ? 1.0f : 0.0f, h == 0 ? 1.0f : 0.0f};
    f32x16 Oacc[2][2];
#pragma unroll
    for (int qs = 0; qs < 2; ++qs)
#pragma unroll
        for (int dh = 0; dh < 2; ++dh)
#pragma unroll
            for (int r = 0; r < 16; ++r) Oacc[qs][dh][r] = 0.f;
    const int skey = tid >> 3, sch = tid & 7;
    const size_t gcol = (size_t)kvh * 64 + sch * 8;
    u32x4 kreg, vreg;
    { const int rb = crow0; kreg = *(const u32x4*)(Kb + (size_t)(rb + skey) * 256 + gcol); vreg = *(const u32x4*)(Vb + (size_t)(rb + skey) * 256 + gcol); }
    for (int ti = 0; ti < ntile; ++ti) {
        LAS unsigned char* kb = lds + ATT_K + (ti & 1) * 64 * KSTR; LAS unsigned char* vb = lds + ATT_V + (ti & 1) * 64 * VSTR;
        *(LAS u32x4*)(kb + skey * KSTR + sch * 16) = kreg; *(LAS u32x4*)(vb + skey * VSTR + sch * 16) = vreg;
        __syncthreads();
        if (ti + 1 < ntile) { const int tn = ti + 1; const int rb = tn < 4 ? crow0 + 64 * tn : lrow0 + 64 * (jlo + tn - 4);
            kreg = *(const u32x4*)(Kb + (size_t)(rb + skey) * 256 + gcol); vreg = *(const u32x4*)(Vb + (size_t)(rb + skey) * 256 + gcol); }
        const int jl = ti < 4 ? -1 : jlo + ti - 4;
        const bool masked = (jl == 0) || (jl == 4);
        const int kp0 = qpos0 - 128 + 64 * jl;
        bf16x8 Kf[2][4];
#pragma unroll
        for (int kt = 0; kt < 2; ++kt)
#pragma unroll
            for (int ks = 0; ks < 4; ++ks) Kf[kt][ks] = *(const LAS bf16x8*)(kb + (32 * kt + l31) * KSTR + (16 * ks + 8 * h) * 2);
#pragma unroll
        for (int qs = 0; qs < 2; ++qs) {
            f32x16 S[2];
#pragma unroll
            for (int kt = 0; kt < 2; ++kt) {
#pragma unroll
                for (int r = 0; r < 16; ++r) S[kt][r] = 0.f;
#pragma unroll
                for (int ks = 0; ks < 4; ++ks) S[kt] = __builtin_amdgcn_mfma_f32_32x32x16_bf16(Kf[kt][ks], Qf[qs][ks], S[kt], 0, 0, 0);
            }
            if (masked) {
                const int qp = qpos0 + 32 * qs + l31;
#pragma unroll
                for (int kt = 0; kt < 2; ++kt)
#pragma unroll
                    for (int r = 0; r < 16; ++r) { const int dlt = kp0 + 32 * kt + (r & 3) + 8 * (r >> 2) + 4 * h - qp; if (dlt > 128 || dlt < -128) S[kt][r] = -INFINITY; }
            }
            float mx = S[0][0];
#pragma unroll
            for (int kt = 0; kt < 2; ++kt)
#pragma unroll
                for (int r = 0; r < 16; ++r) mx = fmaxf(mx, S[kt][r]);
            mx = fmaxf(mx, xor_lane(mx, lane, 32));
            const float mnew = fmaxf(mrow[qs], mx);
            const float alpha = __builtin_amdgcn_exp2f(mrow[qs] - mnew);
            mrow[qs] = mnew;
            float ps = 0.f;
#pragma unroll
            for (int kt = 0; kt < 2; ++kt)
#pragma unroll
                for (int r = 0; r < 16; ++r) { S[kt][r] = __builtin_amdgcn_exp2f(S[kt][r] - mnew); ps += S[kt][r]; }
            lsum[qs] = lsum[qs] * alpha + ps;
#pragma unroll
            for (int dh = 0; dh < 2; ++dh)
#pragma unroll
                for (int r = 0; r < 16; ++r) Oacc[qs][dh][r] *= alpha;
#pragma unroll
            for (int s = 0; s < 4; ++s) {
                const int kt = s >> 1, sp = s & 1;
                u32x4 pw; pw.x = cvt_pk_bf16(S[kt][8 * sp + 0], S[kt][8 * sp + 1]); pw.y = cvt_pk_bf16(S[kt][8 * sp + 2], S[kt][8 * sp + 3]);
                pw.z = cvt_pk_bf16(S[kt][8 * sp + 4], S[kt][8 * sp + 5]); pw.w = cvt_pk_bf16(S[kt][8 * sp + 6], S[kt][8 * sp + 7]);
                const bf16x8 Pf = __builtin_bit_cast(bf16x8, pw);
#pragma unroll
                for (int dh = 0; dh < 2; ++dh) {
                    const int g1 = (lane >> 4) & 1, li = lane & 15, q4 = li >> 2, p4 = li & 3;
                    const LAS unsigned char* va = vb + (16 * s + 4 * h + q4) * VSTR + (32 * dh + 16 * g1 + 4 * p4) * 2;
                    const s16x4 lo = vtr(va), hi = vtr(va + 8 * VSTR);
                    const bf16x8 Vf = (bf16x8){lo[0], lo[1], lo[2], lo[3], hi[0], hi[1], hi[2], hi[3]};
                    Oacc[qs][dh] = __builtin_amdgcn_mfma_f32_32x32x16_bf16(Vf, Pf, Oacc[qs][dh], 0, 0, 0);
                }
            }
        }
    }
#pragma unroll
    for (int qs = 0; qs < 2; ++qs) {
        const float lt = lsum[qs] + xor_lane(lsum[qs], lane, 32);
        const float inv = 1.0f / lt;
        bf16_t* orow = O + (size_t)(qrow0 + 32 * qs + l31) * D + head * 64;
#pragma unroll
        for (int dh = 0; dh < 2; ++dh)
#pragma unroll
            for (int rg = 0; rg < 4; ++rg) {
                u32x2 w; w.x = cvt_pk_bf16(Oacc[qs][dh][4 * rg + 0] * inv, Oacc[qs][dh][4 * rg + 1] * inv); w.y = cvt_pk_bf16(Oacc[qs][dh][4 * rg + 2] * inv, Oacc[qs][dh][4 * rg + 3] * inv);
                *(u32x2*)(orow + 32 * dh + 8 * rg + 4 * h) = w;
            }
    }
    __syncthreads();
}


#define XB_TMO      128
#define XB_XCNT(j)  (256  + 64 * (j))
#define XB_XSUB(j)  (1280 + 64 * (j))
#define XB_XGEN(j)  (2304 + 64 * (j))
#define XB_TOP      3328
#define XB_TOPGEN   3392
#define XCD_BAR_WORDS 3456
#define XB_SPIN_CAP (1u << 18)
__device__ __forceinline__ unsigned xb_ld(unsigned* p)              { return __hip_atomic_load(p, __ATOMIC_RELAXED, __HIP_MEMORY_SCOPE_AGENT); }
__device__ __forceinline__ unsigned xb_add(unsigned* p, unsigned v) { return __hip_atomic_fetch_add(p, v, __ATOMIC_RELAXED, __HIP_MEMORY_SCOPE_AGENT); }
__device__ __forceinline__ unsigned xb_xcc_id() { return (unsigned)__builtin_amdgcn_s_getreg((3 << 11) | 20) & 0xFu; }
#define XB_SPIN(cond, bar) do { unsigned _sp = 0; while (cond) { __builtin_amdgcn_s_sleep(1); \
    if ((++_sp & 255u) == 0u) { if (xb_ld(&(bar)[XB_TMO])) break; if (_sp > XB_SPIN_CAP) { atomicAdd(&(bar)[XB_TMO], 1u); break; } } } } while (0)
struct XcdBarrier { unsigned* bar; unsigned x; volatile LAS unsigned* st; };
__device__ __forceinline__ XcdBarrier xcd_barrier_post(unsigned* bar, volatile LAS unsigned* st) {
    XcdBarrier b; b.bar = bar; b.x = xb_xcc_id(); b.st = st;
    if (threadIdx.x == 0) (void)xb_add(&bar[XB_XCNT(b.x)], 1u);
    return b;
}
__device__ __forceinline__ void xcd_barrier_complete(unsigned* bar, unsigned x, unsigned& nloc, unsigned& nx) {
    const unsigned G = gridDim.x * gridDim.y * gridDim.z;
    unsigned sum, cnt, mine, sp = 0u;
    for (;;) {
        sum = 0u; cnt = 0u; mine = 0u;
#pragma unroll
        for (unsigned j = 0; j < 16; ++j) { const unsigned c = xb_ld(&bar[XB_XCNT(j)]); sum += c; cnt += (c > 0u) ? 1u : 0u; mine = (j == x) ? c : mine; }
        if (sum == G) break;
        __builtin_amdgcn_s_sleep(1);
        if ((++sp & 255u) == 0u) { if (xb_ld(&bar[XB_TMO])) break; if (sp > XB_SPIN_CAP) { atomicAdd(&bar[XB_TMO], 1u); break; } }
    }
    nloc = mine > 0u ? mine : 1u; nx = cnt > 0u ? cnt : 1u;
}
__device__ __forceinline__ void xcd_barrier(const XcdBarrier& b) {
    asm volatile("s_waitcnt vmcnt(0)" ::: "memory");
    __syncthreads();
    if (threadIdx.x == 0) {
        unsigned* bar = b.bar;
        __builtin_amdgcn_s_waitcnt(0);
        unsigned nloc = b.st[0], nx = b.st[1];
        if (nloc == 0u) { xcd_barrier_complete(bar, b.x, nloc, nx); b.st[0] = nloc; b.st[1] = nx; }
        const unsigned old = xb_add(&bar[XB_XSUB(b.x)], 1u);
        const unsigned gen = old / nloc;
        if (old + 1u == (gen + 1u) * nloc) {
            __builtin_amdgcn_fence(__ATOMIC_RELEASE, "agent");
            asm volatile("s_waitcnt vmcnt(0)" ::: "memory");
            const unsigned og = xb_add(&bar[XB_TOP], 1u);
            const unsigned tg = og / nx;
            if (og + 1u == (tg + 1u) * nx) xb_add(&bar[XB_TOPGEN], 1u);
            else XB_SPIN(xb_ld(&bar[XB_TOPGEN]) == tg, bar);
            __builtin_amdgcn_fence(__ATOMIC_ACQUIRE, "agent");
            xb_add(&bar[XB_XGEN(b.x)], 1u);
            asm volatile("s_waitcnt vmcnt(0)" ::: "memory");
        } else {
            XB_SPIN(xb_ld(&bar[XB_XGEN(b.x)]) == gen, bar);
            __builtin_amdgcn_fence(__ATOMIC_ACQUIRE, "agent");
            asm volatile("s_waitcnt vmcnt(0)" ::: "memory");
        }
    }
    __syncthreads();
}

constexpr int LDS_BYTES = 147456;
constexpr int NPHASE = 18;


#define x_in      (a.in[0])
#define c_in      (a.in[1])
#define ctx_in    (a.in[2])
#define cctx_in   (a.in[3])
#define ada_w     (a.in[4])
#define ada_b     (a.in[5])
#define norm1_g   (a.in[6])
#define norm2_g   (a.in[7])
#define w_in      (a.in[8])
#define conv_w    (a.in[9])
#define conv_b    (a.in[10])
#define sink      (a.in[11])
#define w_attn_out (a.in[12])
#define w_conv_out (a.in[13])
#define w_o       (a.in[14])
#define w_ffn_in  (a.in[15])
#define w_ffn_out (a.in[16])
#define final_g   (a.in[17])
#define out       (a.out)
#define ws        (a.ws)
#define ADA  ((float*)(ws + WS_ADA))
#define ROPE ((float*)(ws + WS_ROPE))
#define XC   ((float*)(ws + WS_XC))
#define Hb   ((bf16_t*)(ws + WS_H))
#define Qb   ((bf16_t*)(ws + WS_Q))
#define CBb  ((bf16_t*)(ws + WS_CB))
#define Ub   ((bf16_t*)(ws + WS_U))
#define RHOb ((bf16_t*)(ws + WS_RHO))
#define SCb  ((bf16_t*)(ws + WS_SC))
#define Kb   ((bf16_t*)(ws + WS_K))
#define Vb   ((bf16_t*)(ws + WS_V))
#define HIDb ((bf16_t*)(ws + WS_HID))
#define Mb   Ub
#define PARTb ((float*)(ws + WS_PART))
__global__ void __launch_bounds__(512, 2) fwd_kernel(const Args a) {
    extern __shared__ __attribute__((aligned(16))) unsigned char lds_raw[];
    LAS unsigned char* lds = (LAS unsigned char*)lds_raw;
    cg::grid_group grid = cg::this_grid();
    const int G = gridDim.x, bx = blockIdx.x;
    volatile LAS unsigned* lctl = (volatile LAS unsigned*)(lds + 131072);
    if (threadIdx.x < 16) lctl[threadIdx.x] = 0u;
    __syncthreads();
    const XcdBarrier xbar = xcd_barrier_post((unsigned*)ws + 4096, lctl + 8);
    for (int ph = a.ph_lo; ph < a.ph_hi; ++ph) {
        int tid = threadIdx.x; asm volatile("" : "+v"(tid));
        const int lane = tid & 63, wave = __builtin_amdgcn_readfirstlane(tid >> 6);
        const int gw = bx * 8 + wave, NGW = G * 8;
        if (ph == 0) {
          for (int rep = 0; rep < REP_P0; ++rep) {
            LAS float* scr = (LAS float*)(lds + wave * 16384);
            constexpr int I_IN = 32 * (NIN / 32), I_SQ = 32 * 64, I_F1 = 32 * (NF1 / 32), I_F2 = (DFF / 64) * 64, I_L = I_IN + 3 * I_SQ + I_F1 + I_F2;
            for (int it = gw; it < DEPTH * I_L; it += NGW) {
                const int l = it / I_L; int r = it % I_L; unsigned char* wl = ws + WS_W + (size_t)l * W_LAYER;
                if (r < I_IN) { transpose_item(w_in + (size_t)l * D * NIN, D, NIN, NIN, 1, (bf16_t*)(wl + W_IN), scr, r, lane); continue; } r -= I_IN;
                if (r < I_SQ) { transpose_item(w_attn_out + (size_t)l * D * D, D, D, D, 0, (bf16_t*)(wl + W_A), scr, r, lane); continue; } r -= I_SQ;
                if (r < I_SQ) { transpose_item(w_conv_out + (size_t)l * D * D, D, D, D, 0, (bf16_t*)(wl + W_C), scr, r, lane); continue; } r -= I_SQ;
                if (r < I_SQ) { transpose_item(w_o + (size_t)l * D * D, D, D, D, 0, (bf16_t*)(wl + W_O), scr, r, lane); continue; } r -= I_SQ;
                if (r < I_F1) { transpose_item(w_ffn_in + (size_t)l * D * NF1, D, NF1, NF1, 2, (bf16_t*)(wl + W_F1), scr, r, lane); continue; } r -= I_F1;
                transpose_item(w_ffn_out + (size_t)l * DFF * D, DFF, D, D, 0, (bf16_t*)(wl + W_F2), scr, r, lane);
            }
            __syncthreads();
            LAS float* sl = (LAS float*)lds;
            LAS float* red = (LAS float*)(lds + 3 * 2048 * 4);
            for (int i = tid; i < 3 * 2048; i += 512) { const int v = i >> 11, k = i & 2047; const float cv = v < 2 ? c_in[v * 2048 + k] : cctx_in[k]; sl[i] = cv / (1.0f + __expf(-cv)); }
            __syncthreads();
            for (int it = bx; it < DEPTH * 256; it += G) {
                const int l = it / 256, j0 = (it % 256) * 48;
                const float* wp = ada_w + (size_t)l * D * 12288 + (size_t)(wave * 256) * 12288 + j0 + (lane < 48 ? lane : 0);
                float a0 = 0.f, a1 = 0.f, a2 = 0.f;
#pragma unroll 8
                for (int k = 0; k < 256; ++k) { const float w = wp[(size_t)k * 12288]; const int kk = wave * 256 + k; a0 += sl[kk] * w; a1 += sl[2048 + kk] * w; a2 += sl[4096 + kk] * w; }
                red[(wave * 3 + 0) * 64 + lane] = a0; red[(wave * 3 + 1) * 64 + lane] = a1; red[(wave * 3 + 2) * 64 + lane] = a2;
                __syncthreads();
                if (tid < 192 && (tid & 63) < 48) { const int v = tid >> 6, jl = tid & 63; float s = ada_b[l * 12288 + j0 + jl];
#pragma unroll
                    for (int w8 = 0; w8 < 8; ++w8) s += red[(w8 * 3 + v) * 64 + jl];
                    ADA[(l * 3 + v) * 12288 + j0 + jl] = s; }
                __syncthreads();
            }
            if (bx == (G > 1 ? 1 : 0)) {
                for (int i = tid; i < 2048; i += 512) { const int pos = i >> 4, f = i & 15;
                    float fq_;
                    switch (f) { case 0: fq_ = 1.f; break; case 1: fq_ = 0.562341325f; break; case 2: fq_ = 0.316227766f; break; case 3: fq_ = 0.177827941f; break;
                        case 4: fq_ = 0.1f; break; case 5: fq_ = 0.0562341325f; break; case 6: fq_ = 0.0316227766f; break; case 7: fq_ = 0.0177827941f; break;
                        case 8: fq_ = 0.01f; break; case 9: fq_ = 0.00562341325f; break; case 10: fq_ = 0.00316227766f; break; case 11: fq_ = 0.00177827941f; break;
                        case 12: fq_ = 0.001f; break; case 13: fq_ = 0.000562341325f; break; case 14: fq_ = 0.000316227766f; break; default: fq_ = 0.000177827941f; break; }
                    float sn, cs; sincos_f32((float)pos * fq_, sn, cs); ROPE[i] = cs; ROPE[2048 + i] = sn; }
            }
          __syncthreads(); }
        } else if (ph == NPHASE - 1) {
            for (int m = gw; m < ML; m += NGW) {
                f32x4* xr = (f32x4*)(out + (size_t)m * D) + lane; f32x4 v[8]; float ss = 0.f;
#pragma unroll
                for (int j = 0; j < 8; ++j) { v[j] = xr[64 * j]; ss += (v[j].x * v[j].x + v[j].y * v[j].y) + (v[j].z * v[j].z + v[j].w * v[j].w); }
                const float rs = rsqrtf(wave_sum(ss, lane) * (1.0f / D) + EPS);
#pragma unroll
                for (int j = 0; j < 8; ++j) { const f32x4 g = ((const f32x4*)final_g)[64 * j + lane]; xr[64 * j] = v[j] * rs * g; }
            }
        } else {
            const int l = (ph - 1) / 8, sp = (ph - 1) % 8;
            unsigned char* wl = ws + WS_W + (size_t)l * W_LAYER;
            const float* ada = ADA + (size_t)l * 3 * 12288;
            const float* xl_cur = l == 0 ? x_in : out; const float* xc_cur = l == 0 ? ctx_in : XC;
            if (sp == 0 || sp == 5) {
                const float* xl = sp == 0 ? xl_cur : out; const float* xc = sp == 0 ? xc_cur : XC;
                const float* ng = (sp == 0 ? norm1_g : norm2_g) + l * D; const int so = sp == 0 ? 0 : 3 * 2048;
                const int mend = (sp == 5 && l == DEPTH - 1) ? ML : MT;
                const int nks = (sp == 5 && l == 0) ? 4 : ((sp == 0 && l == 1) ? 11 : 0);
                const float* pgate = ADA + 2 * 12288 + (sp == 5 ? 2 * 2048 : 5 * 2048);
                const float* xcs = (sp == 5 && l == 0) ? ctx_in : xc;
                const int NWC = nks > 4 ? 512 : 256; const bool cw_ = nks > 0 && gw < NWC && NGW > 2 * NWC, lw_ = nks > 0 && !cw_ && NGW > 2 * NWC;
                const int m_beg = cw_ ? ML + gw : (lw_ ? gw - NWC : gw), m_str = cw_ ? NWC : (lw_ ? NGW - NWC : NGW), m_end = cw_ ? MT : (lw_ ? ML : mend);
                for (int rep = 0; rep < REP_NORM; ++rep)
                for (int m = m_beg; m < m_end; m += m_str) {
                    const bool lat = m < ML; const float* xr = lat ? xl + (size_t)m * D : xcs + (size_t)(m - ML) * D; const int vec = lat ? (m >> 13) : 2;
                    const float* shp = ada + vec * 12288 + so; const float* scp = shp + 2048;
                    f32x4 v[8]; float ss = 0.f;
#pragma unroll
                    for (int j = 0; j < 8; ++j) v[j] = ((const f32x4*)xr)[64 * j + lane];
                    if (!lat && nks > 0) {
                        f32x4 ps[8];
#pragma unroll
                        for (int j = 0; j < 8; ++j) ps[j] = (f32x4){0.f, 0.f, 0.f, 0.f};
#pragma unroll 2
                        for (int kc = 0; kc < nks; ++kc) { const f32x4* pp = (const f32x4*)(PARTb + (size_t)kc * MC * D + (size_t)(m - ML) * D);
#pragma unroll
                            for (int j = 0; j < 8; ++j) ps[j] += pp[64 * j + lane]; }
#pragma unroll
                        for (int j = 0; j < 8; ++j) { v[j] += ((const f32x4*)pgate)[64 * j + lane] * ps[j]; if (sp == 5) ((f32x4*)(XC + (size_t)(m - ML) * D))[64 * j + lane] = v[j]; }
                    }
#pragma unroll
                    for (int j = 0; j < 8; ++j) ss += (v[j].x * v[j].x + v[j].y * v[j].y) + (v[j].z * v[j].z + v[j].w * v[j].w);
                    const float rs = rsqrtf(wave_sum(ss, lane) * (1.0f / D) + EPS);
                    u32x2* o8 = (u32x2*)(Hb + (size_t)m * D) + lane;
#pragma unroll
                    for (int j = 0; j < 8; ++j) { const f32x4 g = ((const f32x4*)ng)[64 * j + lane], sc = ((const f32x4*)scp)[64 * j + lane], sh = ((const f32x4*)shp)[64 * j + lane];
                        const f32x4 y = (v[j] * rs) * g * (sc + 1.0f) + sh; u32x2 w; w.x = cvt_pk_bf16(y.x, y.y); w.y = cvt_pk_bf16(y.z, y.w); o8[64 * j] = w; }
                }
            } else if (sp == 1) {
                pg8::Sched S; S.G = G; S.c = bx; S.mode = 0; S.nN = NIN / 256; S.tstep = (size_t)256 * D * 2; S.ks = 1; S.ntfull = D / 64;
                if (l == DEPTH - 1) { S.nM = 64; S.nwg = 64 * S.nN; S.extra = 4; } else { S.nM = 66; S.nwg = 66 * S.nN; S.extra = 0; }
                S.A0 = S.A1 = (const char*)Hb; S.B0 = S.B1 = (const char*)(wl + W_IN);
                EpiInProj E{Qb, Kb, Vb, CBb, Ub, RHOb, SCb, ROPE};
                for (int rep = 0; rep < REP_INPROJ; ++rep)
                pg8::gemm_phase<D / 64>(lds, D, S, E);
            } else if (sp == 2) {
                const int nlat = BATCH * NKV * (SEQ / 64), nctx = (l == DEPTH - 1) ? 0 : BATCH * NKV * (CTXL / 64);
                for (int rep = 0; rep < REP_ATT; ++rep)
                for (int u = bx; u < nlat + nctx; u += G) {
                    if (u < nlat) { const int qb = u % (SEQ / 64), kvh = (u / (SEQ / 64)) % NKV, b = u / ((SEQ / 64) * NKV); const int q0 = qb * 64;
                        const int jlo = q0 >= 128 ? 0 : (q0 >= 64 ? 1 : 2); const int jhi = q0 + 192 <= SEQ ? 4 : (q0 + 128 <= SEQ ? 3 : 2);
                        attn_unit(lds, Qb, Kb, Vb, Hb, sink + l * 32, b * SEQ + q0, kvh, ML + b * CTXL, b * SEQ + q0 - 128, jlo, jhi, q0);
                    } else { const int e = u - nlat; const int qb = e % 4, kvh = (e / 4) % NKV, b = e / 16;
                        attn_unit(lds, Qb, Kb, Vb, Hb, sink + l * 32, ML + b * CTXL + qb * 64, kvh, ML + b * CTXL, 0, 0, -1, 0); }
                }
                const int mend = (l == DEPTH - 1) ? ML : MT;
                const float* cw = conv_w + l * 3 * D; const float* cbias = conv_b + l * D;
                for (int m = gw; m < mend; m += NGW) {
                    const bool lat = m < ML; const int t = lat ? (m & (SEQ - 1)) : ((m - ML) & (CTXL - 1)); const int tl = lat ? SEQ - 1 : CTXL - 1;
                    const bool hp = t > 0, hn = t < tl;
#pragma unroll
                    for (int j = 0; j < 4; ++j) {
                        const int c0 = (64 * j + lane) * 8; const size_t o = (size_t)m * D + c0;
                        const u32x4 zz = (u32x4){0u, 0u, 0u, 0u};
                        const u32x4 up = hp ? *(const u32x4*)(Ub + o - D) : zz, uc = *(const u32x4*)(Ub + o), un = hn ? *(const u32x4*)(Ub + o + D) : zz, cb = *(const u32x4*)(CBb + o);
                        const f32x4 w0a = *(const f32x4*)(cw + c0), w0b = *(const f32x4*)(cw + c0 + 4), w1a = *(const f32x4*)(cw + D + c0), w1b = *(const f32x4*)(cw + D + c0 + 4);
                        const f32x4 w2a = *(const f32x4*)(cw + 2 * D + c0), w2b = *(const f32x4*)(cw + 2 * D + c0 + 4), ba = *(const f32x4*)(cbias + c0), bb = *(const f32x4*)(cbias + c0 + 4);
#define UNPK_LO(q) ((f32x4){bf_lo(q.x), bf_hi(q.x), bf_lo(q.y), bf_hi(q.y)})
#define UNPK_HI(q) ((f32x4){bf_lo(q.z), bf_hi(q.z), bf_lo(q.w), bf_hi(q.w)})
                        const f32x4 ya = UNPK_LO(cb) * (w0a * UNPK_LO(up) + w1a * UNPK_LO(uc) + w2a * UNPK_LO(un) + ba);
                        const f32x4 yb = UNPK_HI(cb) * (w0b * UNPK_HI(up) + w1b * UNPK_HI(uc) + w2b * UNPK_HI(un) + bb);
#undef UNPK_LO
#undef UNPK_HI
                        *(u32x4*)(CBb + o) = pack8(ya, yb);
                    }
                }
            } else if (sp == 3) {
                pg8::Sched S; S.G = G; S.c = bx; S.mode = 1; S.nN = D / 256; S.tstep = (size_t)256 * D * 2; S.extra = 0; S.ks = 1; S.ntfull = D / 64;
                S.nM = 64; S.nwg = S.nM * S.nN; if (l == 0) S.extra = 32;
                S.A0 = (const char*)Hb; S.A1 = (const char*)CBb; S.B0 = (const char*)(wl + W_A); S.B1 = (const char*)(wl + W_C);
                EpiMerge E{RHOb, SCb, Mb, PARTb};
                for (int rep = 0; rep < REP_MERGE; ++rep)
                pg8::gemm_phase<D / 64>(lds, D, S, E);
            } else if (sp == 4) {
                pg8::Sched S; S.G = G; S.c = bx; S.nN = D / 256; S.tstep = (size_t)256 * D * 2; S.ntfull = D / 64;
                S.nM = 64; S.nwg = S.nM * S.nN; S.ks = 4; S.mode = 0; S.extra = 0;
                S.A0 = S.A1 = (const char*)Mb; S.B0 = S.B1 = (const char*)(wl + W_O);
                EpiResid E{xl_cur, xc_cur, out, XC, ada + 2 * 2048, PARTb};
                if (l == 0) {
                    const float* p4 = PARTb + (size_t)4 * MC * D; const float* p5 = PARTb + (size_t)5 * MC * D;
                    for (int i = bx * 512 + tid; i < MC * D / 8; i += G * 512) {
                        const f32x4 a0 = *(const f32x4*)(p4 + (size_t)i * 8) + *(const f32x4*)(p5 + (size_t)i * 8), a1 = *(const f32x4*)(p4 + (size_t)i * 8 + 4) + *(const f32x4*)(p5 + (size_t)i * 8 + 4);
                        *(u32x4*)(Mb + (size_t)ML * D + (size_t)i * 8) = pack8(a0, a1); }
                }
                pg8::gemm_phase<D / 64>(lds, D, S, E);
                if (l == 0) { xcd_barrier(xbar); S.mode = 2; S.nwg = 0; S.extra = 16 * S.ks; S.c = (bx + 128) % G; pg8::gemm_phase<8>(lds, D, S, E); }
            } else if (sp == 6) {
                pg8::Sched S; S.G = G; S.c = bx; S.mode = 0; S.nN = NF1 / 256; S.tstep = (size_t)256 * D * 2; S.extra = 0; S.ks = 1; S.ntfull = D / 64;
                S.nM = (l == DEPTH - 1) ? 64 : 66; S.nwg = S.nM * S.nN;
                S.A0 = S.A1 = (const char*)Hb; S.B0 = S.B1 = (const char*)(wl + W_F1);
                EpiSwiglu E{HIDb};
                for (int rep = 0; rep < REP_FFN1; ++rep)
                pg8::gemm_phase<D / 64>(lds, D, S, E);
            } else if (sp == 7) {
                pg8::Sched S; S.G = G; S.c = bx; S.nN = D / 256; S.tstep = (size_t)256 * DFF * 2; S.ntfull = DFF / 64;
                S.nM = 64; S.nwg = S.nM * S.nN; S.ks = 11; S.mode = 0; S.extra = 0;
                S.A0 = S.A1 = (const char*)HIDb; S.B0 = S.B1 = (const char*)(wl + W_F2);
                EpiResid E{out, XC, out, XC, ada + 5 * 2048, PARTb};
                pg8::gemm_phase<DFF / 64>(lds, DFF, S, E);
                if (l == 0) { S.mode = 2; S.nwg = 0; S.extra = 16 * S.ks; pg8::gemm_phase<8>(lds, DFF, S, E); }
            }
        }
        if (ph + 1 < a.ph_hi) for (int rep = 0; rep < REP_SYNC; ++rep) { if (a.ph_hi > 1000) grid.sync(); else xcd_barrier(xbar); }
    }
}

#undef x_in
#undef c_in
#undef ctx_in
#undef cctx_in
#undef ada_w
#undef ada_b
#undef norm1_g
#undef norm2_g
#undef w_in
#undef conv_w
#undef conv_b
#undef sink
#undef w_attn_out
#undef w_conv_out
#undef w_o
#undef w_ffn_in
#undef w_ffn_out
#undef final_g
#undef out
#undef ws
#undef ADA
#undef ROPE
#undef XC
#undef Hb
#undef Qb
#undef CBb
#undef Ub
#undef RHOb
#undef SCb
#undef Kb
#undef Vb
#undef HIDb
#undef Mb
#undef PARTb
extern "C" void kernel_launch(void* const* d_in, const int* in_sizes, int n_in, void* d_out, int out_size, void* d_ws, size_t ws_size, hipStream_t stream) {
    static int grid = 0;
    if (grid == 0) {
        if (n_in != 18 || out_size != ML * D || ws_size < WS_END) { fprintf(stderr, "kernel_launch: unexpected problem (n_in %d, out %d, ws %zu)\n", n_in, out_size, ws_size); grid = -1; return; }
        int dev = 0, cus = 0, per_cu = 0;
        (void)hipGetDevice(&dev); (void)hipDeviceGetAttribute(&cus, hipDeviceAttributeMultiprocessorCount, dev);
        if (hipFuncSetAttribute((const void*)fwd_kernel, hipFuncAttributeMaxDynamicSharedMemorySize, LDS_BYTES) != hipSuccess) { fprintf(stderr, "kernel_launch: hipFuncSetAttribute failed\n"); grid = -1; return; }
        if (hipOccupancyMaxActiveBlocksPerMultiprocessor(&per_cu, (const void*)fwd_kernel, 512, LDS_BYTES) != hipSuccess || per_cu < 1) per_cu = 1;
        (void)hipGetLastError();
        grid = cus * 1;
    }
    if (grid < 0) return;
    (void)hipMemsetAsync(d_ws, 0, 65536, stream);
    Args a{};
    for (int i = 0; i < 18; ++i) a.in[i] = (const float*)d_in[i];
    a.out = (float*)d_out; a.ws = (unsigned char*)d_ws;
#if MK_MULTI
    for (int ph = 0; ph < NPHASE; ++ph) { a.ph_lo = ph; a.ph_hi = ph + 1; if (ph) (void)hipMemsetAsync(d_ws, 0, 65536, stream); hipLaunchKernelGGL(fwd_kernel, dim3(grid), dim3(512), LDS_BYTES, stream, a); }
#else
    a.ph_lo = 0; a.ph_hi = NPHASE;
    void* args[] = {&a};
    hipError_t e = hipLaunchCooperativeKernel((const void*)fwd_kernel, dim3(grid), dim3(512), args, LDS_BYTES, stream);
    if (e != hipSuccess) fprintf(stderr, "cooperative launch failed: %s (grid %d)\n", hipGetErrorString(e), grid);
#endif
}
```

```cpp
#include <hip/hip_runtime.h>
#include <hip/hip_cooperative_groups.h>
#include <cstdio>
#include <cstdint>
namespace cg = cooperative_groups;

#ifndef REP_P0
#define REP_P0 1
#endif
#ifndef REP_ATT
#define REP_ATT 1
#endif
#ifndef REP_NORM
#define REP_NORM 1
#endif
#ifndef REP_INPROJ
#define REP_INPROJ 1
#endif
#ifndef REP_MERGE
#define REP_MERGE 1
#endif
#ifndef REP_FFN1
#define REP_FFN1 1
#endif
#ifndef REP_SYNC
#define REP_SYNC 1
#endif
#ifndef MK_MULTI
#define MK_MULTI 0
#endif

#define LAS __attribute__((address_space(3)))
typedef unsigned short bf16_t;
typedef short bf16x8 __attribute__((ext_vector_type(8)));
typedef short s16x4 __attribute__((ext_vector_type(4)));
typedef float f32x4 __attribute__((ext_vector_type(4)));
typedef float f32x16 __attribute__((ext_vector_type(16)));
typedef unsigned u32x4 __attribute__((ext_vector_type(4)));
typedef unsigned u32x2 __attribute__((ext_vector_type(2)));

constexpr int D = 2048, BATCH = 2, SEQ = 8192, ML = BATCH * SEQ, CTXL = 256, MC = BATCH * CTXL, MT = ML + MC;
constexpr int NKV = 4, HD = 64, DFF = 5632, NIN = 12800, NF1 = 2 * DFF, DEPTH = 2;
constexpr int OFF_CC = 4608, OFF_CX = 6656, OFF_GA = 8704, OFF_GC = 10752;
constexpr float EPS = 1e-6f;
constexpr float QSCALE = 0.125f * 1.4426950408889634f;
constexpr float LOG2E = 1.4426950408889634f;

constexpr size_t MiB = 1u << 20;
constexpr size_t WS_ADA = 1 * MiB;
constexpr size_t WS_ROPE = 1 * MiB + 512 * 1024;
constexpr size_t WS_XC = 2 * MiB;
constexpr size_t WS_W = 8 * MiB;
constexpr size_t W_LAYER = 140 * MiB, W_IN = 0, W_A = 50 * MiB, W_C = 58 * MiB, W_O = 66 * MiB, W_F1 = 74 * MiB, W_F2 = 118 * MiB;
constexpr size_t WS_H = 288 * MiB;
constexpr size_t WS_Q = 354 * MiB;
constexpr size_t WS_CB = 420 * MiB;
constexpr size_t WS_U = 486 * MiB;
constexpr size_t WS_RHO = 552 * MiB;
constexpr size_t WS_SC = 618 * MiB;
constexpr size_t WS_K = 684 * MiB;
constexpr size_t WS_V = 693 * MiB;
constexpr size_t WS_HID = WS_Q;
constexpr size_t WS_PART = 702 * MiB;
constexpr size_t WS_XB = 746 * MiB;
constexpr size_t WS_END = 810 * MiB;

__device__ __forceinline__ int lane_id() { return (int)__builtin_amdgcn_mbcnt_hi(~0u, __builtin_amdgcn_mbcnt_lo(~0u, 0u)); }
__device__ __forceinline__ int tid_of(int wave_s) { return (wave_s << 6) | lane_id(); }
__device__ __forceinline__ unsigned cvt_pk_bf16(float lo, float hi) { unsigned r; asm volatile("v_cvt_pk_bf16_f32 %0, %1, %2" : "=v"(r) : "v"(lo), "v"(hi)); return r; }
__device__ __forceinline__ float bf_lo(unsigned u) { return __uint_as_float(u << 16); }
__device__ __forceinline__ float bf_hi(unsigned u) { return __uint_as_float(u & 0xffff0000u); }
__device__ __forceinline__ float xor_lane(float v, int lane, int mask) { return __int_as_float(__builtin_amdgcn_ds_bpermute((lane ^ mask) << 2, __float_as_int(v))); }
__device__ __forceinline__ float wave_sum(float v, int lane) {
#pragma unroll
    for (int o = 1; o < 64; o <<= 1) v += xor_lane(v, lane, o);
    return v;
}
__device__ __forceinline__ float fast_sigmoid(float x) { return __builtin_amdgcn_rcpf(1.0f + __builtin_amdgcn_exp2f(-x * LOG2E)); }

namespace pg8 {
constexpr int BM = 256, BK = 64, HALF = 128, HTB = HALF * BK * 2, STAGE_BYTES = 8 * HTB, NXCD = 8, WGM = 8;
__device__ __forceinline__ int lds_byte(int r, int c) { const int st = (r >> 4) * 2 + (c >> 5), rr = r & 15, cc = c & 31, ob = rr * 64 + cc * 2; return st * 1024 + (ob ^ (((ob >> 9) & 1) << 5)); }
__device__ __forceinline__ void stage_rc(int b, int& R, int& C) { const int st = b / 1024, sb = b % 1024, swz = sb ^ (((sb >> 9) & 1) << 5); R = (st >> 1) * 16 + swz / 64; C = (st & 1) * 32 + (swz % 64) / 2; }
__device__ __forceinline__ int perm32(int rho) { const int n = rho >> 4, i = rho & 15; return 8 * (i >> 2) + 4 * n + (i & 3); }

struct Unit { int pm, pn, src, nt, koff; };

struct Sched {
    int nM, nN, nwg, G, c, mode, extra, ks, ntfull;
    const char *A0, *A1, *B0, *B1; size_t tstep;
    __device__ __forceinline__ bool next(int i, Unit& u) const {
        const int ti = mode == 1 ? (i >> 1) : i; u.src = mode == 1 ? (i & 1) : 0; u.nt = ntfull; u.koff = 0;
        const long L = (long)ti * G + c;
        if (L >= nwg + extra) return false;
        if (L >= nwg) { const int e = (int)L - nwg;
            if (mode == 1) { if (i & 1) return false; const int tile = e >> 1; u.pm = 64 + (tile >> 3); u.pn = tile & 7; u.src = 4 + (e & 1); }
            else if (mode == 2) { const int tile = e / ks, kc = e % ks; u.pm = 64 + (tile >> 3); u.pn = tile & 7; u.src = 2 + kc; u.nt = 8; u.koff = kc * 1024; }
            else { u.pm = 64 + (e >> 1); u.pn = 8 + (e & 1); }
            return true; }
        int wgid = (int)L; { const int q = nwg / NXCD, r = nwg % NXCD, xcd = wgid % NXCD, off = wgid / NXCD; wgid = (xcd < r ? xcd * (q + 1) : r * (q + 1) + (xcd - r) * q) + off; }
        const int nig = WGM * nN, gid = wgid / nig, fm = gid * WGM, gsz = (nM - fm) < WGM ? (nM - fm) : WGM;
        u.pm = fm + ((wgid % nig) % gsz); u.pn = (wgid % nig) / gsz; return true;
    }
    __device__ __forceinline__ const char* a_base(const Unit& u) const { return ((u.src == 1 || u.src == 5) ? A1 : A0) + (size_t)u.pm * tstep + u.koff; }
    __device__ __forceinline__ const char* b_base(const Unit& u) const { return ((u.src == 1 || u.src == 5) ? B1 : B0) + (size_t)u.pn * tstep + u.koff; }
};

template <int NT, class Epi>
__device__ __forceinline__ void gemm_phase(LAS unsigned char* lds, const int K, const Sched& S, const Epi& E, const int wave_s) {
    int tid = tid_of(wave_s); asm volatile("" : "+v"(tid));
    const int wid = __builtin_amdgcn_readfirstlane(tid >> 6), lane = tid & 63, wr = wid >> 2, wc = wid & 3, fr = lane & 15, fq = lane >> 4;
    unsigned voffA[2], voffB[2];
#pragma unroll
    for (int i = 0; i < 2; ++i) { int R, C; stage_rc(tid * 16 + i * 8192, R, C); const int Rb = (R & ~31) + perm32(R & 31);
        voffA[i] = (unsigned)(R * K + C) * 2u; voffB[i] = (unsigned)(Rb * K + C) * 2u; }
    const size_t kstep = (size_t)(BK * 2);
    const size_t hstep = (size_t)HALF * K * 2;
    const unsigned ldsw = (unsigned)wid * 1024u;
    const int aoff = lds_byte(wr * 64 + fr, fq * 8), boff = lds_byte(wc * 32 + fr, fq * 8);
    const unsigned ldsa = (unsigned)(size_t)lds + (unsigned)aoff, ldsb = (unsigned)(size_t)lds + (unsigned)boff;
#define PG8_SA(b, h) (((b) * 2 + (h)) * HTB)
#define PG8_SB(b, h) ((4 + (b) * 2 + (h)) * HTB)
#define PG8_STAGE(bufoff, gbase, voff) do { _Pragma("unroll") for (int _i = 0; _i < 2; ++_i) \
        __builtin_amdgcn_global_load_lds((const unsigned*)((const char*)(gbase) + (voff)[_i]), (LAS unsigned*)(lds + (bufoff) + ldsw + _i * 8192), 16, 0, 0); } while (0)
#define PG8_DSR(dst, addr, off) asm volatile("ds_read_b128 %0, %1 offset:%2" : "=v"(dst) : "v"(addr), "n"(off))
#define PG8_LDA(dst, b, h) do { const unsigned _a = ldsa + PG8_SA(b, h); _Pragma("unroll") for (int m = 0; m < 4; ++m) _Pragma("unroll") for (int k = 0; k < 2; ++k) PG8_DSR(dst[m][k], _a, m * 2048 + k * 1024); } while (0)
#define PG8_LDB(dst, b, h) do { const unsigned _b = ldsb + PG8_SB(b, h); _Pragma("unroll") for (int n = 0; n < 2; ++n) _Pragma("unroll") for (int k = 0; k < 2; ++k) PG8_DSR(dst[n][k], _b, n * 2048 + k * 1024); } while (0)
#define PG8_MMA(ai, bj, At, Bt) do { __builtin_amdgcn_s_setprio(1); _Pragma("unroll") for (int m = 0; m < 4; ++m) _Pragma("unroll") for (int n = 0; n < 2; ++n) _Pragma("unroll") for (int k = 0; k < 2; ++k) \
        acc[ai][bj][m][n] = __builtin_amdgcn_mfma_f32_16x16x32_bf16(Bt[n][k], At[m][k], acc[ai][bj][m][n], 0, 0, 0); __builtin_amdgcn_s_setprio(0); } while (0)
#define PG8_WAIT_V(n) asm volatile("s_waitcnt vmcnt(" #n ")" ::: "memory")
#define PG8_WAIT_L(n) asm volatile("s_waitcnt lgkmcnt(" #n ")" ::: "memory")
#define PG8_BAR __builtin_amdgcn_s_barrier()
#define PG8_SCHED __builtin_amdgcn_sched_barrier(0)
    Unit cur, nxt; int ui = 0;
    if (!S.next(0, cur)) return;
    __builtin_amdgcn_s_waitcnt(0);
    f32x4 acc[2][2][4][2];
#pragma unroll
    for (int a = 0; a < 2; ++a)
#pragma unroll
        for (int b = 0; b < 2; ++b)
#pragma unroll
            for (int m = 0; m < 4; ++m)
#pragma unroll
                for (int n = 0; n < 2; ++n) acc[a][b][m][n] = (f32x4){0.f, 0.f, 0.f, 0.f};
    bf16x8 At[4][2], B0[2][2], B1[2][2];
    const char* cA = S.a_base(cur); const char* cB = S.b_base(cur);
    PG8_STAGE(PG8_SB(0, 0), cB, voffB); PG8_STAGE(PG8_SB(0, 1), cB + hstep, voffB); PG8_STAGE(PG8_SA(0, 0), cA, voffA); PG8_STAGE(PG8_SA(0, 1), cA + hstep, voffA);
    if (wr == 1) PG8_BAR;
    PG8_WAIT_V(2); PG8_BAR;
    PG8_STAGE(PG8_SB(1, 0), cB + kstep, voffB); PG8_STAGE(PG8_SA(1, 0), cA + kstep, voffA); PG8_STAGE(PG8_SB(1, 1), cB + hstep + kstep, voffB);
    PG8_WAIT_V(6); PG8_BAR;
    for (;;) {
        const bool has_next = S.next(ui + 1, nxt);
        const char* nA = has_next ? S.a_base(nxt) : cA; const char* nB = has_next ? S.b_base(nxt) : cB;
        constexpr int nt = NT;
        for (int t = 0; t < nt; t += 2) {
            const bool last = (t == nt - 2);
            asm volatile(".p2align 4" ::: "memory");
            const char* a1 = cA + (size_t)(t + 1) * kstep;
            const char* a2 = last ? nA : cA + (size_t)(t + 2) * kstep; const char* b2 = last ? nB : cB + (size_t)(t + 2) * kstep;
            const char* a3 = a2 + kstep; const char* b3 = b2 + kstep;
            PG8_LDB(B0, 0, 0); PG8_LDB(B1, 0, 1); PG8_SCHED; PG8_LDA(At, 0, 0); PG8_STAGE(PG8_SA(1, 1), a1 + hstep, voffA);
            PG8_WAIT_V(8); PG8_WAIT_L(0); PG8_BAR; PG8_MMA(0, 0, At, B0); PG8_MMA(0, 1, At, B1); PG8_BAR; PG8_SCHED;
            PG8_LDA(At, 0, 1); PG8_STAGE(PG8_SB(0, 0), b2, voffB); PG8_STAGE(PG8_SB(0, 1), b2 + hstep, voffB); PG8_STAGE(PG8_SA(0, 0), a2, voffA);
            PG8_WAIT_V(8); PG8_WAIT_L(0); PG8_BAR; PG8_MMA(1, 0, At, B0); PG8_MMA(1, 1, At, B1); PG8_BAR; PG8_SCHED;
            PG8_LDB(B0, 1, 0); PG8_LDB(B1, 1, 1); PG8_SCHED; PG8_LDA(At, 1, 0); PG8_STAGE(PG8_SA(0, 1), a2 + hstep, voffA);
            PG8_WAIT_V(8); PG8_WAIT_L(0); PG8_BAR; PG8_MMA(0, 0, At, B0); PG8_MMA(0, 1, At, B1); PG8_BAR; PG8_SCHED;
            PG8_LDA(At, 1, 1); PG8_STAGE(PG8_SB(1, 0), b3, voffB); PG8_STAGE(PG8_SB(1, 1), b3 + hstep, voffB); PG8_STAGE(PG8_SA(1, 0), a3, voffA);
            PG8_WAIT_V(8); PG8_WAIT_L(0); PG8_BAR; PG8_MMA(1, 0, At, B0); PG8_MMA(1, 1, At, B1); PG8_BAR; PG8_SCHED;
        }
        if (wr == 0) PG8_BAR;
        const bool keep = E(acc, cur, wr, wc, fr, fq);
        __builtin_amdgcn_s_waitcnt(0x0F70);
        if (!has_next) break;
        if (!keep) {
#pragma unroll
            for (int a = 0; a < 2; ++a)
#pragma unroll
                for (int b = 0; b < 2; ++b)
#pragma unroll
                    for (int m = 0; m < 4; ++m)
#pragma unroll
                        for (int n = 0; n < 2; ++n) acc[a][b][m][n] = (f32x4){0.f, 0.f, 0.f, 0.f};
        }
        cur = nxt; cA = nA; cB = nB; ++ui;
        if (wr == 1) PG8_BAR;
    }
    PG8_WAIT_V(0);
    PG8_BAR;
#undef PG8_SA
#undef PG8_SB
#undef PG8_STAGE
#undef PG8_LDA
#undef PG8_DSR
#undef PG8_LDB
#undef PG8_MMA
#undef PG8_WAIT_V
#undef PG8_WAIT_L
#undef PG8_BAR
#undef PG8_SCHED
}
}
using pg8::Unit;

__device__ __forceinline__ u32x4 pack8(const f32x4 a, const f32x4 b) { u32x4 w; w.x = cvt_pk_bf16(a[0], a[1]); w.y = cvt_pk_bf16(a[2], a[3]); w.z = cvt_pk_bf16(b[0], b[1]); w.w = cvt_pk_bf16(b[2], b[3]); return w; }

struct EpiInProj {
    bf16_t *Q, *Kb, *Vb, *CB, *U, *RHO, *SC; const float* rope;
    __device__ __forceinline__ bool operator()(f32x4 (&acc)[2][2][4][2], const Unit& u, int wr, int wc, int fr, int fq) const {
        const int row0 = u.pm * 256 + wr * 64 + fr, pn = u.pn, cw = wc * 32 + fq * 8;
        if (pn <= 8) {
            bf16_t* dst = pn < 8 ? Q : Kb; const int ld = pn < 8 ? D : 256; const int cbase = pn < 8 ? pn * 256 : 0; const float sc = pn < 8 ? QSCALE : 1.0f;
            const bool lat = u.pm < 64;
#pragma unroll
            for (int ai = 0; ai < 2; ++ai) {
                f32x4 cvv[4], svv[4];
#pragma unroll
                for (int m = 0; m < 4; ++m) {
                    const int row = row0 + ai * 128 + m * 16; const int t = row & (SEQ - 1);
                    const int pos = (wc & 1) ? (t & 63) : (t >> 6);
                    cvv[m] = (f32x4){1.f, 1.f, 1.f, 1.f}; svv[m] = (f32x4){0.f, 0.f, 0.f, 0.f};
                    if (lat) { cvv[m] = *(const f32x4*)(rope + pos * 16 + 4 * fq); svv[m] = *(const f32x4*)(rope + 2048 + pos * 16 + 4 * fq); }
                }
                __builtin_amdgcn_sched_barrier(0);
#pragma unroll
                for (int m = 0; m < 4; ++m) {
                    const int row = row0 + ai * 128 + m * 16; const f32x4 cv = cvv[m], sv = svv[m];
#pragma unroll
                    for (int bj = 0; bj < 2; ++bj) {
                        const f32x4 x1 = acc[ai][bj][m][0], x2 = acc[ai][bj][m][1];
                        const f32x4 y1 = (x1 * cv - x2 * sv) * sc, y2 = (x2 * cv + x1 * sv) * sc;
                        *(u32x4*)(dst + (size_t)row * ld + cbase + bj * 128 + cw) = pack8(y1, y2);
                    }
                }
                __builtin_amdgcn_sched_barrier(0);
            }
        } else if (pn <= 17) {
            bf16_t* dst = pn == 9 ? Vb : CB; const int ld = pn == 9 ? 256 : D; const int cbase = pn == 9 ? 0 : (pn - 10) * 256;
#pragma unroll
            for (int ai = 0; ai < 2; ++ai)
#pragma unroll
                for (int m = 0; m < 4; ++m) {
                    const int row = row0 + ai * 128 + m * 16;
#pragma unroll
                    for (int bj = 0; bj < 2; ++bj) *(u32x4*)(dst + (size_t)row * ld + cbase + bj * 128 + cw) = pack8(acc[ai][bj][m][0], acc[ai][bj][m][1]);
                }
        } else if (pn <= 33) {
            const int cbase = (pn - 18) * 128 + cw;
#pragma unroll
            for (int ai = 0; ai < 2; ++ai)
#pragma unroll
                for (int m = 0; m < 4; ++m) {
                    const int row = row0 + ai * 128 + m * 16;
                    *(u32x4*)(U + (size_t)row * D + cbase) = pack8(acc[ai][0][m][0] * acc[ai][1][m][0], acc[ai][0][m][1] * acc[ai][1][m][1]);
                }
        } else {
            const int cbase = (pn - 34) * 128 + cw;
#pragma unroll
            for (int ai = 0; ai < 2; ++ai)
#pragma unroll
                for (int m = 0; m < 4; ++m) {
                    const int row = row0 + ai * 128 + m * 16;
                    f32x4 r0, r1, s0, s1;
#pragma unroll
                    for (int j = 0; j < 4; ++j) {
                        const float ea0 = __builtin_amdgcn_exp2f(-acc[ai][0][m][0][j] * LOG2E), ea1 = __builtin_amdgcn_exp2f(-acc[ai][0][m][1][j] * LOG2E);
                        const float ec0 = __builtin_amdgcn_exp2f(-acc[ai][1][m][0][j] * LOG2E), ec1 = __builtin_amdgcn_exp2f(-acc[ai][1][m][1][j] * LOG2E);
                        s0[j] = __builtin_amdgcn_rcpf(1.0f + ec0); s1[j] = __builtin_amdgcn_rcpf(1.0f + ec1);
                        r0[j] = (1.0f + ec0) * __builtin_amdgcn_rcpf(1.0f + ea0); r1[j] = (1.0f + ec1) * __builtin_amdgcn_rcpf(1.0f + ea1);
                    }
                    *(u32x4*)(RHO + (size_t)row * D + cbase) = pack8(r0, r1);
                    *(u32x4*)(SC + (size_t)row * D + cbase) = pack8(s0, s1);
                }
        }
        return false;
    }
};

struct EpiMerge {
    const bf16_t *RHO, *SC; bf16_t* Mo; float* part;
    __device__ __forceinline__ bool operator()(f32x4 (&acc)[2][2][4][2], const Unit& u, int wr, int wc, int fr, int fq) const {
        const int row0 = u.pm * 256 + wr * 64 + fr, c0 = u.pn * 256 + wc * 32 + fq * 8;
        const bf16_t* G = u.src == 0 ? RHO : SC;
        float* pd = part + (size_t)u.src * MC * D - (size_t)ML * D;
#pragma unroll
        for (int b4 = 0; b4 < 4; ++b4) {
            const int ai = b4 >> 1, mh = (b4 & 1) * 2;
            u32x4 gq[2][2];
#pragma unroll
            for (int mm = 0; mm < 2; ++mm)
#pragma unroll
                for (int bj = 0; bj < 2; ++bj) { const size_t ro = (size_t)(row0 + ai * 128 + (mh + mm) * 16) * D + c0 + bj * 128;
                    gq[mm][bj] = *(const u32x4*)(G + ro); }
            __builtin_amdgcn_sched_barrier(0);
#pragma unroll
            for (int mm = 0; mm < 2; ++mm)
#pragma unroll
                for (int bj = 0; bj < 2; ++bj) { const size_t ro = (size_t)(row0 + ai * 128 + (mh + mm) * 16) * D + c0 + bj * 128; const int m = mh + mm;
                    const u32x4 g = gq[mm][bj];
                    f32x4 g0 = (f32x4){bf_lo(g.x), bf_hi(g.x), bf_lo(g.y), bf_hi(g.y)}, g1 = (f32x4){bf_lo(g.z), bf_hi(g.z), bf_lo(g.w), bf_hi(g.w)};
                    if (u.src == 4) { const u32x4 r = *(const u32x4*)(RHO + ro);
                        g0 *= (f32x4){bf_lo(r.x), bf_hi(r.x), bf_lo(r.y), bf_hi(r.y)}; g1 *= (f32x4){bf_lo(r.z), bf_hi(r.z), bf_lo(r.w), bf_hi(r.w)}; }
                    acc[ai][bj][m][0] *= g0; acc[ai][bj][m][1] *= g1;
                    if (u.src == 1) *(u32x4*)(Mo + ro) = pack8(acc[ai][bj][m][0], acc[ai][bj][m][1]);
                    if (u.src >= 4) { *(f32x4*)(pd + ro) = acc[ai][bj][m][0]; *(f32x4*)(pd + ro + 4) = acc[ai][bj][m][1]; }
                }
            __builtin_amdgcn_sched_barrier(0);
        }
        return u.src == 0;
    }
};

struct EpiResid {
    bf16_t* xb; const float* gate; float* part;
    __device__ __forceinline__ bool operator()(f32x4 (&acc)[2][2][4][2], const Unit& u, int wr, int wc, int fr, int fq) const {
        if (u.src >= 2) {
            float* pd = part + (size_t)(u.src - 2) * MC * D + (size_t)((u.pm - 64) * 256 + wr * 64 + fr) * D + u.pn * 256 + wc * 32 + fq * 8;
#pragma unroll
            for (int ai = 0; ai < 2; ++ai)
#pragma unroll
                for (int m = 0; m < 4; ++m)
#pragma unroll
                    for (int bj = 0; bj < 2; ++bj) { float* q = pd + (size_t)(ai * 128 + m * 16) * D + bj * 128; *(f32x4*)q = acc[ai][bj][m][0]; *(f32x4*)(q + 4) = acc[ai][bj][m][1]; }
            return false;
        }
        const int vec = u.pm >> 5;
        const int row0 = u.pm * 256 + wr * 64 + fr, c0 = u.pn * 256 + wc * 32 + fq * 8;
        const float* gp = gate + vec * 12288 + c0;
        f32x4 gv[2][2];
#pragma unroll
        for (int bj = 0; bj < 2; ++bj) { gv[bj][0] = *(const f32x4*)(gp + bj * 128); gv[bj][1] = *(const f32x4*)(gp + bj * 128 + 4); }
#pragma unroll
        for (int b4 = 0; b4 < 4; ++b4) {
            const int ai = b4 >> 1, mh = (b4 & 1) * 2;
            u32x4 xq[2][2];
#pragma unroll
            for (int mm = 0; mm < 2; ++mm)
#pragma unroll
                for (int bj = 0; bj < 2; ++bj) xq[mm][bj] = *(const u32x4*)(xb + (size_t)(row0 + ai * 128 + (mh + mm) * 16) * D + c0 + bj * 128);
            __builtin_amdgcn_sched_barrier(0);
#pragma unroll
            for (int mm = 0; mm < 2; ++mm)
#pragma unroll
                for (int bj = 0; bj < 2; ++bj)
                { const u32x4 q = xq[mm][bj]; const f32x4 x0 = (f32x4){bf_lo(q.x), bf_hi(q.x), bf_lo(q.y), bf_hi(q.y)}, x1 = (f32x4){bf_lo(q.z), bf_hi(q.z), bf_lo(q.w), bf_hi(q.w)};
                    *(u32x4*)(xb + (size_t)(row0 + ai * 128 + (mh + mm) * 16) * D + c0 + bj * 128) = pack8(x0 + gv[bj][0] * acc[ai][bj][mh + mm][0], x1 + gv[bj][1] * acc[ai][bj][mh + mm][1]); }
            __builtin_amdgcn_sched_barrier(0);
        }
        return false;
    }
};

struct EpiSwiglu {
    bf16_t* HID;
    __device__ __forceinline__ bool operator()(f32x4 (&acc)[2][2][4][2], const Unit& u, int wr, int wc, int fr, int fq) const {
        const int row0 = u.pm * 256 + wr * 64 + fr, c0 = u.pn * 128 + wc * 32 + fq * 8;
#pragma unroll
        for (int ai = 0; ai < 2; ++ai)
#pragma unroll
            for (int m = 0; m < 4; ++m) {
                f32x4 h0, h1;
#pragma unroll
                for (int j = 0; j < 4; ++j) {
                    const float g0 = acc[ai][0][m][0][j], g1 = acc[ai][0][m][1][j];
                    h0[j] = g0 * fast_sigmoid(g0) * acc[ai][1][m][0][j]; h1[j] = g1 * fast_sigmoid(g1) * acc[ai][1][m][1][j];
                }
                *(u32x4*)(HID + (size_t)(row0 + ai * 128 + m * 16) * DFF + c0) = pack8(h0, h1);
            }
        return false;
    }
};

struct Args {
    const float* in[18]; float* out; unsigned char* ws; int ph_lo, ph_hi;
};

__device__ __forceinline__ int src_group_base(int kind, int n0, bool& ropeperm) {
    ropeperm = false;
    if (kind == 0) return n0;
    const int pn = n0 >> 8, off = n0 & 255;
    if (kind == 1) {
        if (pn <= 8) { ropeperm = true; return n0; }
        if (pn <= 17) return n0;
        if (pn <= 33) { const int j = pn - 18; return off < 128 ? OFF_CC + 128 * j + off : OFF_CX + 128 * j + off - 128; }
        const int j = pn - 34; return off < 128 ? OFF_GA + 128 * j + off : OFF_GC + 128 * j + off - 128;
    }
    return off < 128 ? 128 * pn + off : DFF + 128 * pn + off - 128;
}
__device__ __forceinline__ void transpose_item(const float* W, int K, int N, int NP, int kind, bf16_t* WT, LAS float* scr, int item, int lane) {
    const int nblk = NP / 32, kb = item / nblk, nb = item % nblk, k0 = 64 * kb, n0 = 32 * nb;
    bool rp; const int sb = src_group_base(kind, n0, rp);
    const int p = lane & 31; const int so = rp ? (4 * (p >> 3) + (p & 3) + 16 * ((p >> 2) & 1)) : p;
#pragma unroll 8
    for (int i = 0; i < 32; ++i) { const int kk = 2 * i + (lane >> 5); scr[kk * 33 + p] = W[(size_t)(k0 + kk) * N + sb + so]; }
    asm volatile("s_waitcnt lgkmcnt(0)" ::: "memory");
    const int c = lane & 7;
#pragma unroll
    for (int j = 0; j < 4; ++j) { const int n = (lane >> 3) + 8 * j; const LAS float* s = scr + (8 * c) * 33 + n;
        u32x4 o; o.x = cvt_pk_bf16(s[0 * 33], s[1 * 33]); o.y = cvt_pk_bf16(s[2 * 33], s[3 * 33]); o.z = cvt_pk_bf16(s[4 * 33], s[5 * 33]); o.w = cvt_pk_bf16(s[6 * 33], s[7 * 33]);
        *(u32x4*)(WT + (size_t)(n0 + n) * K + k0 + 8 * c) = o; }
    asm volatile("s_waitcnt lgkmcnt(0)" ::: "memory");
}

__device__ __forceinline__ void sincos_f32(float ang, float& sn, float& cs) {
    const float k = rintf(ang * 0.15915494309189535f);
    float r = fmaf(-k, 6.28125f, ang); r = fmaf(-k, 1.935307179586232e-3f, r);
    const float r2 = r * r;
    float ps = -1.0f / 51090942171709440000.0f;
    ps = fmaf(ps, r2, 1.0f / 121645100408832000.0f); ps = fmaf(ps, r2, -1.0f / 355687428096000.0f); ps = fmaf(ps, r2, 1.0f / 1307674368000.0f);
    ps = fmaf(ps, r2, -1.0f / 6227020800.0f); ps = fmaf(ps, r2, 1.0f / 39916800.0f); ps = fmaf(ps, r2, -1.0f / 362880.0f); ps = fmaf(ps, r2, 1.0f / 5040.0f);
    ps = fmaf(ps, r2, -1.0f / 120.0f); ps = fmaf(ps, r2, 1.0f / 6.0f); sn = fmaf(-r * r2, ps, r);
    float pc = 1.0f / 2432902008176640000.0f;
    pc = fmaf(pc, r2, -1.0f / 6402373705728000.0f); pc = fmaf(pc, r2, 1.0f / 20922789888000.0f); pc = fmaf(pc, r2, -1.0f / 87178291200.0f); pc = fmaf(pc, r2, 1.0f / 479001600.0f);
    pc = fmaf(pc, r2, -1.0f / 3628800.0f); pc = fmaf(pc, r2, 1.0f / 40320.0f); pc = fmaf(pc, r2, -1.0f / 720.0f); pc = fmaf(pc, r2, 1.0f / 24.0f); pc = fmaf(pc, r2, -0.5f);
    cs = fmaf(pc, r2, 1.0f);
}

constexpr int KSTR = 144, VSTR = 192;
constexpr int ATT_K = 0, ATT_V = 2 * 64 * KSTR;
__device__ __forceinline__ s16x4 vtr(const LAS unsigned char* p) { return __builtin_bit_cast(s16x4, __builtin_amdgcn_ds_read_tr16_b64_v4i16((LAS s16x4*)p)); }

__device__ __forceinline__ void attn_unit(LAS unsigned char* lds, const bf16_t* Q, const bf16_t* Kb, const bf16_t* Vb, bf16_t* O, const float* sink,
                                          int qrow0, int kvh, int crow0, int lrow0, int jlo, int jhi, int qpos0, const int wave_s) {
    int tid = tid_of(wave_s); asm volatile("" : "+v"(tid));
    const int wid = __builtin_amdgcn_readfirstlane(tid >> 6), lane = tid & 63, l31 = lane & 31, h = lane >> 5;
    const int head = kvh * 8 + wid;
    const int ntile = 4 + (jhi - jlo + 1);
    bf16x8 Qf[2][4];
#pragma unroll
    for (int qs = 0; qs < 2; ++qs)
#pragma unroll
        for (int ks = 0; ks < 4; ++ks) Qf[qs][ks] = *(const bf16x8*)(Q + (size_t)(qrow0 + 32 * qs + l31) * D + head * 64 + 16 * ks + 8 * h);
    const float sk = sink[head] * LOG2E;
    float mrow[2] = {sk, sk}, lsum[2] = {h == 0 ? 1.0f : 0.0f, h == 0 ? 1.0f : 0.0f};
    f32x16 Oacc[2][2];
#pragma unroll
    for (int qs = 0; qs < 2; ++qs)
#pragma unroll
        for (int dh = 0; dh < 2; ++dh)
#pragma unroll
            for (int r = 0; r < 16; ++r) Oacc[qs][dh][r] = 0.f;
    const int skey = tid >> 3, sch = tid & 7;
    const size_t gcol = (size_t)kvh * 64 + sch * 8;
    u32x4 kreg, vreg;
    { const int rb = crow0; kreg = *(const u32x4*)(Kb + (size_t)(rb + skey) * 256 + gcol); vreg = *(const u32x4*)(Vb + (size_t)(rb + skey) * 256 + gcol); }
    for (int ti = 0; ti < ntile; ++ti) {
        LAS unsigned char* kb = lds + ATT_K + (ti & 1) * 64 * KSTR; LAS unsigned char* vb = lds + ATT_V + (ti & 1) * 64 * VSTR;
        *(LAS u32x4*)(kb + skey * KSTR + sch * 16) = kreg; *(LAS u32x4*)(vb + skey * VSTR + sch * 16) = vreg;
        __syncthreads();
        if (ti + 1 < ntile) { const int tn = ti + 1; const int rb = tn < 4 ? crow0 + 64 * tn : lrow0 + 64 * (jlo + tn - 4);
            kreg = *(const u32x4*)(Kb + (size_t)(rb + skey) * 256 + gcol); vreg = *(const u32x4*)(Vb + (size_t)(rb + skey) * 256 + gcol); }
        const int jl = ti < 4 ? -1 : jlo + ti - 4;
        const bool masked = (jl == 0) || (jl == 4);
        const int kp0 = qpos0 - 128 + 64 * jl;
        bf16x8 Kf[2][4];
#pragma unroll
        for (int kt = 0; kt < 2; ++kt)
#pragma unroll
            for (int ks = 0; ks < 4; ++ks) Kf[kt][ks] = *(const LAS bf16x8*)(kb + (32 * kt + l31) * KSTR + (16 * ks + 8 * h) * 2);
#pragma unroll
        for (int qs = 0; qs < 2; ++qs) {
            f32x16 S[2];
#pragma unroll
            for (int kt = 0; kt < 2; ++kt) {
#pragma unroll
                for (int r = 0; r < 16; ++r) S[kt][r] = 0.f;
#pragma unroll
                for (int ks = 0; ks < 4; ++ks) S[kt] = __builtin_amdgcn_mfma_f32_32x32x16_bf16(Kf[kt][ks], Qf[qs][ks], S[kt], 0, 0, 0);
            }
            if (masked) {
                const int qp = qpos0 + 32 * qs + l31;
#pragma unroll
                for (int kt = 0; kt < 2; ++kt)
#pragma unroll
                    for (int r = 0; r < 16; ++r) { const int dlt = kp0 + 32 * kt + (r & 3) + 8 * (r >> 2) + 4 * h - qp; if (dlt > 128 || dlt < -128) S[kt][r] = -INFINITY; }
            }
            float mx = S[0][0];
#pragma unroll
            for (int kt = 0; kt < 2; ++kt)
#pragma unroll
                for (int r = 0; r < 16; ++r) mx = fmaxf(mx, S[kt][r]);
            mx = fmaxf(mx, xor_lane(mx, lane, 32));
            const float mnew = fmaxf(mrow[qs], mx);
            const float alpha = __builtin_amdgcn_exp2f(mrow[qs] - mnew);
            mrow[qs] = mnew;
            float ps = 0.f;
#pragma unroll
            for (int kt = 0; kt < 2; ++kt)
#pragma unroll
                for (int r = 0; r < 16; ++r) { S[kt][r] = __builtin_amdgcn_exp2f(S[kt][r] - mnew); ps += S[kt][r]; }
            lsum[qs] = lsum[qs] * alpha + ps;
#pragma unroll
            for (int dh = 0; dh < 2; ++dh)
#pragma unroll
                for (int r = 0; r < 16; ++r) Oacc[qs][dh][r] *= alpha;
#pragma unroll
            for (int s = 0; s < 4; ++s) {
                const int kt = s >> 1, sp = s & 1;
                u32x4 pw; pw.x = cvt_pk_bf16(S[kt][8 * sp + 0], S[kt][8 * sp + 1]); pw.y = cvt_pk_bf16(S[kt][8 * sp + 2], S[kt][8 * sp + 3]);
                pw.z = cvt_pk_bf16(S[kt][8 * sp + 4], S[kt][8 * sp + 5]); pw.w = cvt_pk_bf16(S[kt][8 * sp + 6], S[kt][8 * sp + 7]);
                const bf16x8 Pf = __builtin_bit_cast(bf16x8, pw);
#pragma unroll
                for (int dh = 0; dh < 2; ++dh) {
                    const int g1 = (lane >> 4) & 1, li = lane & 15, q4 = li >> 2, p4 = li & 3;
                    const LAS unsigned char* va = vb + (16 * s + 4 * h + q4) * VSTR + (32 * dh + 16 * g1 + 4 * p4) * 2;
                    const s16x4 lo = vtr(va), hi = vtr(va + 8 * VSTR);
                    const bf16x8 Vf = (bf16x8){lo[0], lo[1], lo[2], lo[3], hi[0], hi[1], hi[2], hi[3]};
                    Oacc[qs][dh] = __builtin_amdgcn_mfma_f32_32x32x16_bf16(Vf, Pf, Oacc[qs][dh], 0, 0, 0);
                }
            }
        }
    }
#pragma unroll
    for (int qs = 0; qs < 2; ++qs) {
        const float lt = lsum[qs] + xor_lane(lsum[qs], lane, 32);
        const float inv = 1.0f / lt;
        bf16_t* orow = O + (size_t)(qrow0 + 32 * qs + l31) * D + head * 64;
#pragma unroll
        for (int dh = 0; dh < 2; ++dh)
#pragma unroll
            for (int rg = 0; rg < 4; ++rg) {
                u32x2 w; w.x = cvt_pk_bf16(Oacc[qs][dh][4 * rg + 0] * inv, Oacc[qs][dh][4 * rg + 1] * inv); w.y = cvt_pk_bf16(Oacc[qs][dh][4 * rg + 2] * inv, Oacc[qs][dh][4 * rg + 3] * inv);
                *(u32x2*)(orow + 32 * dh + 8 * rg + 4 * h) = w;
            }
    }
    __syncthreads();
}


#define XB_TMO      128
#define XB_XCNT(j)  (256  + 64 * (j))
#define XB_XSUB(j)  (1280 + 64 * (j))
#define XB_XGEN(j)  (2304 + 64 * (j))
#define XB_TOP      3328
#define XB_TOPGEN   3392
#define XCD_BAR_WORDS 3456
#define XB_SPIN_CAP (1u << 18)
__device__ __forceinline__ unsigned xb_ld(unsigned* p)              { return __hip_atomic_load(p, __ATOMIC_RELAXED, __HIP_MEMORY_SCOPE_AGENT); }
__device__ __forceinline__ unsigned xb_add(unsigned* p, unsigned v) { return __hip_atomic_fetch_add(p, v, __ATOMIC_RELAXED, __HIP_MEMORY_SCOPE_AGENT); }
__device__ __forceinline__ unsigned xb_xcc_id() { return (unsigned)__builtin_amdgcn_s_getreg((3 << 11) | 20) & 0xFu; }
#define XB_SPIN(cond, bar) do { unsigned _sp = 0; while (cond) { __builtin_amdgcn_s_sleep(1); \
    if ((++_sp & 255u) == 0u) { if (xb_ld(&(bar)[XB_TMO])) break; if (_sp > XB_SPIN_CAP) { atomicAdd(&(bar)[XB_TMO], 1u); break; } } } } while (0)
struct XcdBarrier { unsigned* bar; unsigned x; volatile LAS unsigned* st; };
__device__ __forceinline__ XcdBarrier xcd_barrier_post(unsigned* bar, volatile LAS unsigned* st, const int wave_s) {
    XcdBarrier b; b.bar = bar; b.x = xb_xcc_id(); b.st = st;
    if (tid_of(wave_s) == 0) (void)xb_add(&bar[XB_XCNT(b.x)], 1u);
    return b;
}
__device__ __forceinline__ void xcd_barrier_complete(unsigned* bar, unsigned x, unsigned& nloc, unsigned& nx) {
    const unsigned G = gridDim.x * gridDim.y * gridDim.z;
    unsigned sum, cnt, mine, sp = 0u;
    for (;;) {
        sum = 0u; cnt = 0u; mine = 0u;
#pragma unroll
        for (unsigned j = 0; j < 16; ++j) { const unsigned c = xb_ld(&bar[XB_XCNT(j)]); sum += c; cnt += (c > 0u) ? 1u : 0u; mine = (j == x) ? c : mine; }
        if (sum == G) break;
        __builtin_amdgcn_s_sleep(1);
        if ((++sp & 255u) == 0u) { if (xb_ld(&bar[XB_TMO])) break; if (sp > XB_SPIN_CAP) { atomicAdd(&bar[XB_TMO], 1u); break; } }
    }
    nloc = mine > 0u ? mine : 1u; nx = cnt > 0u ? cnt : 1u;
}
__device__ __forceinline__ void xcd_barrier(const XcdBarrier& b, const int wave_s) {
    asm volatile("s_waitcnt vmcnt(0)" ::: "memory");
    __syncthreads();
    if (tid_of(wave_s) == 0) {
        unsigned* bar = b.bar;
        __builtin_amdgcn_s_waitcnt(0);
        unsigned nloc = b.st[0], nx = b.st[1];
        if (nloc == 0u) { xcd_barrier_complete(bar, b.x, nloc, nx); b.st[0] = nloc; b.st[1] = nx; }
        const unsigned old = xb_add(&bar[XB_XSUB(b.x)], 1u);
        const unsigned gen = old / nloc;
        if (old + 1u == (gen + 1u) * nloc) {
            __builtin_amdgcn_fence(__ATOMIC_RELEASE, "agent");
            asm volatile("s_waitcnt vmcnt(0)" ::: "memory");
            const unsigned og = xb_add(&bar[XB_TOP], 1u);
            const unsigned tg = og / nx;
            if (og + 1u == (tg + 1u) * nx) xb_add(&bar[XB_TOPGEN], 1u);
            else XB_SPIN(xb_ld(&bar[XB_TOPGEN]) == tg, bar);
            __builtin_amdgcn_fence(__ATOMIC_ACQUIRE, "agent");
            xb_add(&bar[XB_XGEN(b.x)], 1u);
            asm volatile("s_waitcnt vmcnt(0)" ::: "memory");
        } else {
            XB_SPIN(xb_ld(&bar[XB_XGEN(b.x)]) == gen, bar);
            __builtin_amdgcn_fence(__ATOMIC_ACQUIRE, "agent");
            asm volatile("s_waitcnt vmcnt(0)" ::: "memory");
        }
    }
    __syncthreads();
}

constexpr int LDS_BYTES = 147456;
constexpr int NPHASE = 18;


#define x_in      (a.in[0])
#define c_in      (a.in[1])
#define ctx_in    (a.in[2])
#define cctx_in   (a.in[3])
#define ada_w     (a.in[4])
#define ada_b     (a.in[5])
#define norm1_g   (a.in[6])
#define norm2_g   (a.in[7])
#define w_in      (a.in[8])
#define conv_w    (a.in[9])
#define conv_b    (a.in[10])
#define sink      (a.in[11])
#define w_attn_out (a.in[12])
#define w_conv_out (a.in[13])
#define w_o       (a.in[14])
#define w_ffn_in  (a.in[15])
#define w_ffn_out (a.in[16])
#define final_g   (a.in[17])
#define out       (a.out)
#define ws        (a.ws)
#define ADA  ((float*)(ws + WS_ADA))
#define ROPE ((float*)(ws + WS_ROPE))
#define XC   ((float*)(ws + WS_XC))
#define Hb   ((bf16_t*)(ws + WS_H))
#define Qb   ((bf16_t*)(ws + WS_Q))
#define CBb  ((bf16_t*)(ws + WS_CB))
#define Ub   ((bf16_t*)(ws + WS_U))
#define RHOb ((bf16_t*)(ws + WS_RHO))
#define SCb  ((bf16_t*)(ws + WS_SC))
#define Kb   ((bf16_t*)(ws + WS_K))
#define Vb   ((bf16_t*)(ws + WS_V))
#define HIDb ((bf16_t*)(ws + WS_HID))
#define Mb   Ub
#define PARTb ((float*)(ws + WS_PART))
#define XBb  ((bf16_t*)(ws + WS_XB))
__global__ void __launch_bounds__(512, 2) fwd_kernel(const Args a) {
    extern __shared__ __attribute__((aligned(16))) unsigned char lds_raw[];
    LAS unsigned char* lds = (LAS unsigned char*)lds_raw;
    cg::grid_group grid = cg::this_grid();
    const int G = gridDim.x, bx = blockIdx.x;
    volatile LAS unsigned* lctl = (volatile LAS unsigned*)(lds + 131072);
    const int wave_s = __builtin_amdgcn_readfirstlane((int)threadIdx.x >> 6);
    if (tid_of(wave_s) < 16) lctl[tid_of(wave_s)] = 0u;
    __syncthreads();
    const XcdBarrier xbar = xcd_barrier_post((unsigned*)ws + 4096, lctl + 8, wave_s);
    for (int ph = a.ph_lo; ph < a.ph_hi; ++ph) {
        int tid = tid_of(wave_s); asm volatile("" : "+v"(tid));
        const int lane = tid & 63, wave = wave_s;
        const int gw = bx * 8 + wave, NGW = G * 8;
        if (ph == 0) {
          for (int rep = 0; rep < REP_P0; ++rep) {
            LAS float* scr = (LAS float*)(lds + wave * 16384);
            constexpr int I_IN = 32 * (NIN / 32), I_SQ = 32 * 64, I_F1 = 32 * (NF1 / 32), I_F2 = (DFF / 64) * 64, I_L = I_IN + 3 * I_SQ + I_F1 + I_F2;
            for (int it = gw; it < DEPTH * I_L; it += NGW) {
                const int l = it / I_L; int r = it % I_L; unsigned char* wl = ws + WS_W + (size_t)l * W_LAYER;
                if (r < I_IN) { transpose_item(w_in + (size_t)l * D * NIN, D, NIN, NIN, 1, (bf16_t*)(wl + W_IN), scr, r, lane); continue; } r -= I_IN;
                if (r < I_SQ) { transpose_item(w_attn_out + (size_t)l * D * D, D, D, D, 0, (bf16_t*)(wl + W_A), scr, r, lane); continue; } r -= I_SQ;
                if (r < I_SQ) { transpose_item(w_conv_out + (size_t)l * D * D, D, D, D, 0, (bf16_t*)(wl + W_C), scr, r, lane); continue; } r -= I_SQ;
                if (r < I_SQ) { transpose_item(w_o + (size_t)l * D * D, D, D, D, 0, (bf16_t*)(wl + W_O), scr, r, lane); continue; } r -= I_SQ;
                if (r < I_F1) { transpose_item(w_ffn_in + (size_t)l * D * NF1, D, NF1, NF1, 2, (bf16_t*)(wl + W_F1), scr, r, lane); continue; } r -= I_F1;
                transpose_item(w_ffn_out + (size_t)l * DFF * D, DFF, D, D, 0, (bf16_t*)(wl + W_F2), scr, r, lane);
            }
            __syncthreads();
            LAS float* sl = (LAS float*)lds;
            LAS float* red = (LAS float*)(lds + 3 * 2048 * 4);
            for (int i = tid; i < 3 * 2048; i += 512) { const int v = i >> 11, k = i & 2047; const float cv = v < 2 ? c_in[v * 2048 + k] : cctx_in[k]; sl[i] = cv / (1.0f + __expf(-cv)); }
            __syncthreads();
            for (int it = bx; it < DEPTH * 192; it += G) {
                const int l = it / 192, j0 = (it % 192) * 64;
                const float* wp = ada_w + (size_t)l * D * 12288 + (size_t)(wave * 256) * 12288 + j0 + lane;
                float a0 = 0.f, a1 = 0.f, a2 = 0.f;
#pragma unroll 8
                for (int k = 0; k < 256; ++k) { const float w = wp[(size_t)k * 12288]; const int kk = wave * 256 + k; a0 += sl[kk] * w; a1 += sl[2048 + kk] * w; a2 += sl[4096 + kk] * w; }
                red[(wave * 3 + 0) * 64 + lane] = a0; red[(wave * 3 + 1) * 64 + lane] = a1; red[(wave * 3 + 2) * 64 + lane] = a2;
                __syncthreads();
                if (tid < 192) { const int v = tid >> 6, jl = tid & 63; float s = ada_b[l * 12288 + j0 + jl];
#pragma unroll
                    for (int w8 = 0; w8 < 8; ++w8) s += red[(w8 * 3 + v) * 64 + jl];
                    ADA[(l * 3 + v) * 12288 + j0 + jl] = s; }
                __syncthreads();
            }
            if (bx == (G > 1 ? 1 : 0)) {
                for (int i = tid; i < 2048; i += 512) { const int pos = i >> 4, f = i & 15;
                    float fq_;
                    switch (f) { case 0: fq_ = 1.f; break; case 1: fq_ = 0.562341325f; break; case 2: fq_ = 0.316227766f; break; case 3: fq_ = 0.177827941f; break;
                        case 4: fq_ = 0.1f; break; case 5: fq_ = 0.0562341325f; break; case 6: fq_ = 0.0316227766f; break; case 7: fq_ = 0.0177827941f; break;
                        case 8: fq_ = 0.01f; break; case 9: fq_ = 0.00562341325f; break; case 10: fq_ = 0.00316227766f; break; case 11: fq_ = 0.00177827941f; break;
                        case 12: fq_ = 0.001f; break; case 13: fq_ = 0.000562341325f; break; case 14: fq_ = 0.000316227766f; break; default: fq_ = 0.000177827941f; break; }
                    float sn, cs; sincos_f32((float)pos * fq_, sn, cs); ROPE[i] = cs; ROPE[2048 + i] = sn; }
            }
          __syncthreads(); }
        } else if (ph == NPHASE - 1) {
            for (int m = gw; m < ML; m += NGW) {
                const u32x2* xq = (const u32x2*)(XBb + (size_t)m * D); f32x4* xr = (f32x4*)(out + (size_t)m * D) + lane; f32x4 v[8]; float ss = 0.f;
#pragma unroll
                for (int j = 0; j < 8; ++j) { const u32x2 q = xq[64 * j + lane]; v[j] = (f32x4){bf_lo(q.x), bf_hi(q.x), bf_lo(q.y), bf_hi(q.y)}; ss += (v[j].x * v[j].x + v[j].y * v[j].y) + (v[j].z * v[j].z + v[j].w * v[j].w); }
                const float rs = rsqrtf(wave_sum(ss, lane) * (1.0f / D) + EPS);
#pragma unroll
                for (int j = 0; j < 8; ++j) { const f32x4 g = ((const f32x4*)final_g)[64 * j + lane]; xr[64 * j] = v[j] * rs * g; }
            }
        } else {
            const int l = (ph - 1) / 8, sp = (ph - 1) % 8;
            unsigned char* wl = ws + WS_W + (size_t)l * W_LAYER;
            const float* ada = ADA + (size_t)l * 3 * 12288;
            const float* xc_cur = l == 0 ? ctx_in : XC;
            if (sp == 0 || sp == 5) {
                const float* xl = x_in; const float* xc = sp == 0 ? xc_cur : XC; const bool lbf = !(sp == 0 && l == 0);
                const float* ng = (sp == 0 ? norm1_g : norm2_g) + l * D; const int so = sp == 0 ? 0 : 3 * 2048;
                const int mend = (sp == 5 && l == DEPTH - 1) ? ML : MT;
                const int nks = (sp == 5 && l == 0) ? 4 : ((sp == 0 && l == 1) ? 11 : 0);
                const float* pgate = ADA + 2 * 12288 + (sp == 5 ? 2 * 2048 : 5 * 2048);
                const float* xcs = (sp == 5 && l == 0) ? ctx_in : xc;
                const int NWC = nks > 4 ? 512 : 256; const bool cw_ = nks > 0 && gw < NWC && NGW > 2 * NWC, lw_ = nks > 0 && !cw_ && NGW > 2 * NWC;
                const int m_beg = cw_ ? ML + gw : (lw_ ? gw - NWC : gw), m_str = cw_ ? NWC : (lw_ ? NGW - NWC : NGW), m_end = cw_ ? MT : (lw_ ? ML : mend);
                for (int rep = 0; rep < REP_NORM; ++rep)
                for (int m = m_beg; m < m_end; m += m_str) {
                    const bool lat = m < ML; const float* xr = lat ? xl + (size_t)m * D : xcs + (size_t)(m - ML) * D; const int vec = lat ? (m >> 13) : 2;
                    const float* shp = ada + vec * 12288 + so; const float* scp = shp + 2048;
                    f32x4 v[8]; float ss = 0.f;
                    if (lat && lbf) { const u32x2* xq = (const u32x2*)(XBb + (size_t)m * D);
#pragma unroll
                        for (int j = 0; j < 8; ++j) { const u32x2 q = xq[64 * j + lane]; v[j] = (f32x4){bf_lo(q.x), bf_hi(q.x), bf_lo(q.y), bf_hi(q.y)}; }
                    } else {
#pragma unroll
                        for (int j = 0; j < 8; ++j) v[j] = ((const f32x4*)xr)[64 * j + lane];
                        if (lat) { u32x2* xw = (u32x2*)(XBb + (size_t)m * D);
#pragma unroll
                            for (int j = 0; j < 8; ++j) { u32x2 w; w.x = cvt_pk_bf16(v[j].x, v[j].y); w.y = cvt_pk_bf16(v[j].z, v[j].w); xw[64 * j + lane] = w; } }
                    }
                    if (!lat && nks > 0) {
                        f32x4 ps[8];
#pragma unroll
                        for (int j = 0; j < 8; ++j) ps[j] = (f32x4){0.f, 0.f, 0.f, 0.f};
#pragma unroll 2
                        for (int kc = 0; kc < nks; ++kc) { const f32x4* pp = (const f32x4*)(PARTb + (size_t)kc * MC * D + (size_t)(m - ML) * D);
#pragma unroll
                            for (int j = 0; j < 8; ++j) ps[j] += pp[64 * j + lane]; }
#pragma unroll
                        for (int j = 0; j < 8; ++j) { v[j] += ((const f32x4*)pgate)[64 * j + lane] * ps[j]; if (sp == 5) ((f32x4*)(XC + (size_t)(m - ML) * D))[64 * j + lane] = v[j]; }
                    }
#pragma unroll
                    for (int j = 0; j < 8; ++j) ss += (v[j].x * v[j].x + v[j].y * v[j].y) + (v[j].z * v[j].z + v[j].w * v[j].w);
                    const float rs = rsqrtf(wave_sum(ss, lane) * (1.0f / D) + EPS);
                    u32x2* o8 = (u32x2*)(Hb + (size_t)m * D) + lane;
#pragma unroll
                    for (int j = 0; j < 8; ++j) { const f32x4 g = ((const f32x4*)ng)[64 * j + lane], sc = ((const f32x4*)scp)[64 * j + lane], sh = ((const f32x4*)shp)[64 * j + lane];
                        const f32x4 y = (v[j] * rs) * g * (sc + 1.0f) + sh; u32x2 w; w.x = cvt_pk_bf16(y.x, y.y); w.y = cvt_pk_bf16(y.z, y.w); o8[64 * j] = w; }
                }
            } else if (sp == 1) {
                pg8::Sched S; S.G = G; S.c = bx; S.mode = 0; S.nN = NIN / 256; S.tstep = (size_t)256 * D * 2; S.ks = 1; S.ntfull = D / 64;
                if (l == DEPTH - 1) { S.nM = 64; S.nwg = 64 * S.nN; S.extra = 4; } else { S.nM = 66; S.nwg = 66 * S.nN; S.extra = 0; }
                S.A0 = S.A1 = (const char*)Hb; S.B0 = S.B1 = (const char*)(wl + W_IN);
                EpiInProj E{Qb, Kb, Vb, CBb, Ub, RHOb, SCb, ROPE};
                for (int rep = 0; rep < REP_INPROJ; ++rep)
                pg8::gemm_phase<D / 64>(lds, D, S, E, wave_s);
            } else if (sp == 2) {
                const int nlat = BATCH * NKV * (SEQ / 64), nctx = (l == DEPTH - 1) ? 0 : BATCH * NKV * (CTXL / 64);
                for (int rep = 0; rep < REP_ATT; ++rep)
                for (int u = bx; u < nlat + nctx; u += G) {
                    if (u < nlat) { const int qb = u % (SEQ / 64), kvh = (u / (SEQ / 64)) % NKV, b = u / ((SEQ / 64) * NKV); const int q0 = qb * 64;
                        const int jlo = q0 >= 128 ? 0 : (q0 >= 64 ? 1 : 2); const int jhi = q0 + 192 <= SEQ ? 4 : (q0 + 128 <= SEQ ? 3 : 2);
                        attn_unit(lds, Qb, Kb, Vb, Hb, sink + l * 32, b * SEQ + q0, kvh, ML + b * CTXL, b * SEQ + q0 - 128, jlo, jhi, q0, wave_s);
                    } else { const int e = u - nlat; const int qb = e % 4, kvh = (e / 4) % NKV, b = e / 16;
                        attn_unit(lds, Qb, Kb, Vb, Hb, sink + l * 32, ML + b * CTXL + qb * 64, kvh, ML + b * CTXL, 0, 0, -1, 0, wave_s); }
                }
                const int mend = (l == DEPTH - 1) ? ML : MT;
                const float* cw = conv_w + l * 3 * D; const float* cbias = conv_b + l * D;
                for (int m = gw; m < mend; m += NGW) {
                    const bool lat = m < ML; const int t = lat ? (m & (SEQ - 1)) : ((m - ML) & (CTXL - 1)); const int tl = lat ? SEQ - 1 : CTXL - 1;
                    const bool hp = t > 0, hn = t < tl;
#pragma unroll
                    for (int j = 0; j < 4; ++j) {
                        const int c0 = (64 * j + lane) * 8; const size_t o = (size_t)m * D + c0;
                        const u32x4 zz = (u32x4){0u, 0u, 0u, 0u};
                        const u32x4 up = hp ? *(const u32x4*)(Ub + o - D) : zz, uc = *(const u32x4*)(Ub + o), un = hn ? *(const u32x4*)(Ub + o + D) : zz, cb = *(const u32x4*)(CBb + o);
                        const f32x4 w0a = *(const f32x4*)(cw + c0), w0b = *(const f32x4*)(cw + c0 + 4), w1a = *(const f32x4*)(cw + D + c0), w1b = *(const f32x4*)(cw + D + c0 + 4);
                        const f32x4 w2a = *(const f32x4*)(cw + 2 * D + c0), w2b = *(const f32x4*)(cw + 2 * D + c0 + 4), ba = *(const f32x4*)(cbias + c0), bb = *(const f32x4*)(cbias + c0 + 4);
#define UNPK_LO(q) ((f32x4){bf_lo(q.x), bf_hi(q.x), bf_lo(q.y), bf_hi(q.y)})
#define UNPK_HI(q) ((f32x4){bf_lo(q.z), bf_hi(q.z), bf_lo(q.w), bf_hi(q.w)})
                        const f32x4 ya = UNPK_LO(cb) * (w0a * UNPK_LO(up) + w1a * UNPK_LO(uc) + w2a * UNPK_LO(un) + ba);
                        const f32x4 yb = UNPK_HI(cb) * (w0b * UNPK_HI(up) + w1b * UNPK_HI(uc) + w2b * UNPK_HI(un) + bb);
#undef UNPK_LO
#undef UNPK_HI
                        *(u32x4*)(CBb + o) = pack8(ya, yb);
                    }
                }
            } else if (sp == 3) {
                pg8::Sched S; S.G = G; S.c = bx; S.mode = 1; S.nN = D / 256; S.tstep = (size_t)256 * D * 2; S.extra = 0; S.ks = 1; S.ntfull = D / 64;
                S.nM = 64; S.nwg = S.nM * S.nN; if (l == 0) S.extra = 32;
                S.A0 = (const char*)Hb; S.A1 = (const char*)CBb; S.B0 = (const char*)(wl + W_A); S.B1 = (const char*)(wl + W_C);
                EpiMerge E{RHOb, SCb, Mb, PARTb};
                for (int rep = 0; rep < REP_MERGE; ++rep)
                pg8::gemm_phase<D / 64>(lds, D, S, E, wave_s);
            } else if (sp == 4) {
                pg8::Sched S; S.G = G; S.c = bx; S.nN = D / 256; S.tstep = (size_t)256 * D * 2; S.ntfull = D / 64;
                S.nM = 64; S.nwg = S.nM * S.nN; S.ks = 4; S.mode = 0; S.extra = 0;
                S.A0 = S.A1 = (const char*)Mb; S.B0 = S.B1 = (const char*)(wl + W_O);
                EpiResid E{XBb, ada + 2 * 2048, PARTb};
                if (l == 0) {
                    const float* p4 = PARTb + (size_t)4 * MC * D; const float* p5 = PARTb + (size_t)5 * MC * D;
                    for (int i = bx * 512 + tid; i < MC * D / 8; i += G * 512) {
                        const f32x4 a0 = *(const f32x4*)(p4 + (size_t)i * 8) + *(const f32x4*)(p5 + (size_t)i * 8), a1 = *(const f32x4*)(p4 + (size_t)i * 8 + 4) + *(const f32x4*)(p5 + (size_t)i * 8 + 4);
                        *(u32x4*)(Mb + (size_t)ML * D + (size_t)i * 8) = pack8(a0, a1); }
                }
                pg8::gemm_phase<D / 64>(lds, D, S, E, wave_s);
                if (l == 0) { xcd_barrier(xbar, wave_s); S.mode = 2; S.nwg = 0; S.extra = 16 * S.ks; S.c = (bx + 128) % G; pg8::gemm_phase<8>(lds, D, S, E, wave_s); }
            } else if (sp == 6) {
                pg8::Sched S; S.G = G; S.c = bx; S.mode = 0; S.nN = NF1 / 256; S.tstep = (size_t)256 * D * 2; S.extra = 0; S.ks = 1; S.ntfull = D / 64;
                S.nM = (l == DEPTH - 1) ? 64 : 66; S.nwg = S.nM * S.nN;
                S.A0 = S.A1 = (const char*)Hb; S.B0 = S.B1 = (const char*)(wl + W_F1);
                EpiSwiglu E{HIDb};
                for (int rep = 0; rep < REP_FFN1; ++rep)
                pg8::gemm_phase<D / 64>(lds, D, S, E, wave_s);
            } else if (sp == 7) {
                pg8::Sched S; S.G = G; S.c = bx; S.nN = D / 256; S.tstep = (size_t)256 * DFF * 2; S.ntfull = DFF / 64;
                S.nM = 64; S.nwg = S.nM * S.nN; S.ks = 11; S.mode = 0; S.extra = 0;
                S.A0 = S.A1 = (const char*)HIDb; S.B0 = S.B1 = (const char*)(wl + W_F2);
                EpiResid E{XBb, ada + 5 * 2048, PARTb};
                pg8::gemm_phase<DFF / 64>(lds, DFF, S, E, wave_s);
                if (l == 0) { S.mode = 2; S.nwg = 0; S.extra = 16 * S.ks; pg8::gemm_phase<8>(lds, DFF, S, E, wave_s); }
            }
        }
        if (ph + 1 < a.ph_hi) for (int rep = 0; rep < REP_SYNC; ++rep) { if (a.ph_hi > 1000) grid.sync(); else xcd_barrier(xbar, wave_s); }
    }
}

#undef x_in
#undef c_in
#undef ctx_in
#undef cctx_in
#undef ada_w
#undef ada_b
#undef norm1_g
#undef norm2_g
#undef w_in
#undef conv_w
#undef conv_b
#undef sink
#undef w_attn_out
#undef w_conv_out
#undef w_o
#undef w_ffn_in
#undef w_ffn_out
#undef final_g
#undef out
#undef ws
#undef ADA
#undef ROPE
#undef XC
#undef Hb
#undef Qb
#undef CBb
#undef Ub
#undef RHOb
#undef SCb
#undef Kb
#undef Vb
#undef HIDb
#undef Mb
#undef PARTb
#undef XBb
extern "C" void kernel_launch(void* const* d_in, const int* in_sizes, int n_in, void* d_out, int out_size, void* d_ws, size_t ws_size, hipStream_t stream) {
    static int grid = 0;
    if (grid == 0) {
        if (n_in != 18 || out_size != ML * D || ws_size < WS_END) { fprintf(stderr, "kernel_launch: unexpected problem (n_in %d, out %d, ws %zu)\n", n_in, out_size, ws_size); grid = -1; return; }
        int dev = 0, cus = 0, per_cu = 0;
        (void)hipGetDevice(&dev); (void)hipDeviceGetAttribute(&cus, hipDeviceAttributeMultiprocessorCount, dev);
        if (hipFuncSetAttribute((const void*)fwd_kernel, hipFuncAttributeMaxDynamicSharedMemorySize, LDS_BYTES) != hipSuccess) { fprintf(stderr, "kernel_launch: hipFuncSetAttribute failed\n"); grid = -1; return; }
        if (hipOccupancyMaxActiveBlocksPerMultiprocessor(&per_cu, (const void*)fwd_kernel, 512, LDS_BYTES) != hipSuccess || per_cu < 1) per_cu = 1;
        (void)hipGetLastError();
        grid = cus * 1;
    }
    if (grid < 0) return;
    (void)hipMemsetAsync(d_ws, 0, 65536, stream);
    Args a{};
    for (int i = 0; i < 18; ++i) a.in[i] = (const float*)d_in[i];
    a.out = (float*)d_out; a.ws = (unsigned char*)d_ws;
#if MK_MULTI
    for (int ph = 0; ph < NPHASE; ++ph) { a.ph_lo = ph; a.ph_hi = ph + 1; if (ph) (void)hipMemsetAsync(d_ws, 0, 65536, stream); hipLaunchKernelGGL(fwd_kernel, dim3(grid), dim3(512), LDS_BYTES, stream, a); }
#else
    a.ph_lo = 0; a.ph_hi = NPHASE;
    void* args[] = {&a};
    hipError_t e = hipLaunchCooperativeKernel((const void*)fwd_kernel, dim3(grid), dim3(512), args, LDS_BYTES, stream);
    if (e != hipSuccess) fprintf(stderr, "cooperative launch failed: %s (grid %d)\n", hipGetErrorString(e), grid);
#endif
}
```

```cpp
#include <hip/hip_runtime.h>
#include <hip/hip_cooperative_groups.h>
#include <cstdio>
#include <cstdint>
namespace cg = cooperative_groups;

#ifndef REP_P0
#define REP_P0 1
#endif
#ifndef REP_ATT
#define REP_ATT 1
#endif
#ifndef REP_NORM
#define REP_NORM 1
#endif
#ifndef REP_INPROJ
#define REP_INPROJ 1
#endif
#ifndef REP_MERGE
#define REP_MERGE 1
#endif
#ifndef REP_FFN1
#define REP_FFN1 1
#endif
#ifndef REP_SYNC
#define REP_SYNC 1
#endif
#ifndef MK_MULTI
#define MK_MULTI 0
#endif

#define LAS __attribute__((address_space(3)))
typedef unsigned short bf16_t;
typedef short bf16x8 __attribute__((ext_vector_type(8)));
typedef short s16x4 __attribute__((ext_vector_type(4)));
typedef float f32x4 __attribute__((ext_vector_type(4)));
typedef float f32x16 __attribute__((ext_vector_type(16)));
typedef unsigned u32x4 __attribute__((ext_vector_type(4)));
typedef unsigned u32x2 __attribute__((ext_vector_type(2)));

constexpr int D = 2048, BATCH = 2, SEQ = 8192, ML = BATCH * SEQ, CTXL = 256, MC = BATCH * CTXL, MT = ML + MC;
constexpr int NKV = 4, HD = 64, DFF = 5632, NIN = 12800, NF1 = 2 * DFF, DEPTH = 2;
constexpr int OFF_CC = 4608, OFF_CX = 6656, OFF_GA = 8704, OFF_GC = 10752;
constexpr float EPS = 1e-6f;
constexpr float QSCALE = 0.125f * 1.4426950408889634f;
constexpr float LOG2E = 1.4426950408889634f;

constexpr size_t MiB = 1u << 20;
constexpr size_t WS_ADA = 1 * MiB;
constexpr size_t WS_ROPE = 1 * MiB + 512 * 1024;
constexpr size_t WS_XC = 2 * MiB;
constexpr size_t WS_W = 8 * MiB;
constexpr size_t W_LAYER = 140 * MiB, W_IN = 0, W_A = 50 * MiB, W_C = 58 * MiB, W_O = 66 * MiB, W_F1 = 74 * MiB, W_F2 = 118 * MiB;
constexpr size_t WS_H = 288 * MiB;
constexpr size_t WS_Q = 354 * MiB;
constexpr size_t WS_CB = 420 * MiB;
constexpr size_t WS_U = 486 * MiB;
constexpr size_t WS_RHO = 552 * MiB;
constexpr size_t WS_SC = 618 * MiB;
constexpr size_t WS_K = 684 * MiB;
constexpr size_t WS_V = 693 * MiB;
constexpr size_t WS_HID = WS_Q;
constexpr size_t WS_PART = WS_RHO;
constexpr size_t WS_MPART = WS_Q;
constexpr size_t WS_XB = 702 * MiB;
constexpr size_t WS_END = 766 * MiB;

__device__ __forceinline__ int lane_id() { return (int)__builtin_amdgcn_mbcnt_hi(~0u, __builtin_amdgcn_mbcnt_lo(~0u, 0u)); }
__device__ __forceinline__ int tid_of(int wave_s) { return (wave_s << 6) | lane_id(); }
__device__ __forceinline__ unsigned cvt_pk_bf16(float lo, float hi) { unsigned r; asm volatile("v_cvt_pk_bf16_f32 %0, %1, %2" : "=v"(r) : "v"(lo), "v"(hi)); return r; }
__device__ __forceinline__ float bf_lo(unsigned u) { return __uint_as_float(u << 16); }
__device__ __forceinline__ float bf_hi(unsigned u) { return __uint_as_float(u & 0xffff0000u); }
__device__ __forceinline__ float xor_lane(float v, int lane, int mask) { return __int_as_float(__builtin_amdgcn_ds_bpermute((lane ^ mask) << 2, __float_as_int(v))); }
__device__ __forceinline__ float wave_sum(float v, int lane) {
#pragma unroll
    for (int o = 1; o < 64; o <<= 1) v += xor_lane(v, lane, o);
    return v;
}
__device__ __forceinline__ float fast_sigmoid(float x) { return __builtin_amdgcn_rcpf(1.0f + __builtin_amdgcn_exp2f(-x * LOG2E)); }

namespace pg8 {
constexpr int BM = 256, BK = 64, HALF = 128, HTB = HALF * BK * 2, STAGE_BYTES = 8 * HTB, NXCD = 8, WGM = 8;
__device__ __forceinline__ int lds_byte(int r, int c) { const int st = (r >> 4) * 2 + (c >> 5), rr = r & 15, cc = c & 31, ob = rr * 64 + cc * 2; return st * 1024 + (ob ^ (((ob >> 9) & 1) << 5)); }
__device__ __forceinline__ void stage_rc(int b, int& R, int& C) { const int st = b / 1024, sb = b % 1024, swz = sb ^ (((sb >> 9) & 1) << 5); R = (st >> 1) * 16 + swz / 64; C = (st & 1) * 32 + (swz % 64) / 2; }
__device__ __forceinline__ int perm32(int rho) { const int n = rho >> 4, i = rho & 15; return 8 * (i >> 2) + 4 * n + (i & 3); }

struct Unit { int pm, pn, src, nt, koff; };

struct Sched {
    int nM, nN, nwg, G, c, mode, extra, ks, ntfull;
    const char *A0, *A1, *B0, *B1; size_t tstep;
    __device__ __forceinline__ bool next(int i, Unit& u) const {
        const int ti = mode == 1 ? (i >> 1) : i; u.src = mode == 1 ? (i & 1) : 0; u.nt = ntfull; u.koff = 0;
        const long L = (long)ti * G + c;
        if (L >= nwg + extra) return false;
        if (L >= nwg) { const int e = (int)L - nwg;
            if (mode == 1) { if (i & 1) return false; const int tile = e >> 1; u.pm = 64 + (tile >> 3); u.pn = tile & 7; u.src = 4 + (e & 1); }
            else if (mode == 2) { const int tile = e / ks, kc = e % ks; u.pm = 64 + (tile >> 3); u.pn = tile & 7; u.src = 2 + kc; u.nt = 8; u.koff = kc * 1024; }
            else { u.pm = 64 + (e >> 1); u.pn = 8 + (e & 1); }
            return true; }
        int wgid = (int)L; { const int q = nwg / NXCD, r = nwg % NXCD, xcd = wgid % NXCD, off = wgid / NXCD; wgid = (xcd < r ? xcd * (q + 1) : r * (q + 1) + (xcd - r) * q) + off; }
        const int nig = WGM * nN, gid = wgid / nig, fm = gid * WGM, gsz = (nM - fm) < WGM ? (nM - fm) : WGM;
        u.pm = fm + ((wgid % nig) % gsz); u.pn = (wgid % nig) / gsz; return true;
    }
    __device__ __forceinline__ const char* a_base(const Unit& u) const { return ((u.src == 1 || u.src == 5) ? A1 : A0) + (size_t)u.pm * tstep + u.koff; }
    __device__ __forceinline__ const char* b_base(const Unit& u) const { return ((u.src == 1 || u.src == 5) ? B1 : B0) + (size_t)u.pn * tstep + u.koff; }
};

template <int NT, class Epi>
__device__ __forceinline__ void gemm_phase(LAS unsigned char* lds, const int K, const Sched& S, const Epi& E, const int wave_s) {
    int tid = tid_of(wave_s); asm volatile("" : "+v"(tid));
    const int wid = __builtin_amdgcn_readfirstlane(tid >> 6), lane = tid & 63, wr = wid >> 2, wc = wid & 3, fr = lane & 15, fq = lane >> 4;
    unsigned voffA[2], voffB[2];
#pragma unroll
    for (int i = 0; i < 2; ++i) { int R, C; stage_rc(tid * 16 + i * 8192, R, C); const int Rb = (R & ~31) + perm32(R & 31);
        voffA[i] = (unsigned)(R * K + C) * 2u; voffB[i] = (unsigned)(Rb * K + C) * 2u; }
    const size_t kstep = (size_t)(BK * 2);
    const size_t hstep = (size_t)HALF * K * 2;
    const unsigned ldsw = (unsigned)wid * 1024u;
    const int aoff = lds_byte(wr * 64 + fr, fq * 8), boff = lds_byte(wc * 32 + fr, fq * 8);
    const unsigned ldsa = (unsigned)(size_t)lds + (unsigned)aoff, ldsb = (unsigned)(size_t)lds + (unsigned)boff;
#define PG8_SA(b, h) (((b) * 2 + (h)) * HTB)
#define PG8_SB(b, h) ((4 + (b) * 2 + (h)) * HTB)
#define PG8_STAGE(bufoff, gbase, voff) do { _Pragma("unroll") for (int _i = 0; _i < 2; ++_i) \
        __builtin_amdgcn_global_load_lds((const unsigned*)((const char*)(gbase) + (voff)[_i]), (LAS unsigned*)(lds + (bufoff) + ldsw + _i * 8192), 16, 0, 0); } while (0)
#define PG8_DSR(dst, addr, off) asm volatile("ds_read_b128 %0, %1 offset:%2" : "=v"(dst) : "v"(addr), "n"(off))
#define PG8_LDA(dst, b, h) do { const unsigned _a = ldsa + PG8_SA(b, h); _Pragma("unroll") for (int m = 0; m < 4; ++m) _Pragma("unroll") for (int k = 0; k < 2; ++k) PG8_DSR(dst[m][k], _a, m * 2048 + k * 1024); } while (0)
#define PG8_LDB(dst, b, h) do { const unsigned _b = ldsb + PG8_SB(b, h); _Pragma("unroll") for (int n = 0; n < 2; ++n) _Pragma("unroll") for (int k = 0; k < 2; ++k) PG8_DSR(dst[n][k], _b, n * 2048 + k * 1024); } while (0)
#define PG8_MMA(ai, bj, At, Bt) do { __builtin_amdgcn_s_setprio(1); _Pragma("unroll") for (int m = 0; m < 4; ++m) _Pragma("unroll") for (int n = 0; n < 2; ++n) _Pragma("unroll") for (int k = 0; k < 2; ++k) \
        acc[ai][bj][m][n] = __builtin_amdgcn_mfma_f32_16x16x32_bf16(Bt[n][k], At[m][k], acc[ai][bj][m][n], 0, 0, 0); __builtin_amdgcn_s_setprio(0); } while (0)
#define PG8_WAIT_V(n) asm volatile("s_waitcnt vmcnt(" #n ")" ::: "memory")
#define PG8_WAIT_L(n) asm volatile("s_waitcnt lgkmcnt(" #n ")" ::: "memory")
#define PG8_BAR __builtin_amdgcn_s_barrier()
#define PG8_SCHED __builtin_amdgcn_sched_barrier(0)
    Unit cur, nxt; int ui = 0;
    if (!S.next(0, cur)) return;
    __builtin_amdgcn_s_waitcnt(0);
    f32x4 acc[2][2][4][2];
#pragma unroll
    for (int a = 0; a < 2; ++a)
#pragma unroll
        for (int b = 0; b < 2; ++b)
#pragma unroll
            for (int m = 0; m < 4; ++m)
#pragma unroll
                for (int n = 0; n < 2; ++n) acc[a][b][m][n] = (f32x4){0.f, 0.f, 0.f, 0.f};
    bf16x8 At[4][2], B0[2][2], B1[2][2];
    const char* cA = S.a_base(cur); const char* cB = S.b_base(cur);
    PG8_STAGE(PG8_SB(0, 0), cB, voffB); PG8_STAGE(PG8_SB(0, 1), cB + hstep, voffB); PG8_STAGE(PG8_SA(0, 0), cA, voffA); PG8_STAGE(PG8_SA(0, 1), cA + hstep, voffA);
    if (wr == 1) PG8_BAR;
    PG8_WAIT_V(2); PG8_BAR;
    PG8_STAGE(PG8_SB(1, 0), cB + kstep, voffB); PG8_STAGE(PG8_SA(1, 0), cA + kstep, voffA); PG8_STAGE(PG8_SB(1, 1), cB + hstep + kstep, voffB);
    PG8_WAIT_V(6); PG8_BAR;
    for (;;) {
        const bool has_next = S.next(ui + 1, nxt);
        const char* nA = has_next ? S.a_base(nxt) : cA; const char* nB = has_next ? S.b_base(nxt) : cB;
        constexpr int nt = NT;
        for (int t = 0; t < nt; t += 2) {
            const bool last = (t == nt - 2);
            asm volatile(".p2align 4" ::: "memory");
            const char* a1 = cA + (size_t)(t + 1) * kstep;
            const char* a2 = last ? nA : cA + (size_t)(t + 2) * kstep; const char* b2 = last ? nB : cB + (size_t)(t + 2) * kstep;
            const char* a3 = a2 + kstep; const char* b3 = b2 + kstep;
            PG8_LDB(B0, 0, 0); PG8_LDB(B1, 0, 1); PG8_SCHED; PG8_LDA(At, 0, 0); PG8_STAGE(PG8_SA(1, 1), a1 + hstep, voffA);
            PG8_WAIT_V(8); PG8_WAIT_L(0); PG8_BAR; PG8_MMA(0, 0, At, B0); PG8_MMA(0, 1, At, B1); PG8_BAR; PG8_SCHED;
            PG8_LDA(At, 0, 1); PG8_STAGE(PG8_SB(0, 0), b2, voffB); PG8_STAGE(PG8_SB(0, 1), b2 + hstep, voffB); PG8_STAGE(PG8_SA(0, 0), a2, voffA);
            PG8_WAIT_V(8); PG8_WAIT_L(0); PG8_BAR; PG8_MMA(1, 0, At, B0); PG8_MMA(1, 1, At, B1); PG8_BAR; PG8_SCHED;
            PG8_LDB(B0, 1, 0); PG8_LDB(B1, 1, 1); PG8_SCHED; PG8_LDA(At, 1, 0); PG8_STAGE(PG8_SA(0, 1), a2 + hstep, voffA);
            PG8_WAIT_V(8); PG8_WAIT_L(0); PG8_BAR; PG8_MMA(0, 0, At, B0); PG8_MMA(0, 1, At, B1); PG8_BAR; PG8_SCHED;
            PG8_LDA(At, 1, 1); PG8_STAGE(PG8_SB(1, 0), b3, voffB); PG8_STAGE(PG8_SB(1, 1), b3 + hstep, voffB); PG8_STAGE(PG8_SA(1, 0), a3, voffA);
            PG8_WAIT_V(8); PG8_WAIT_L(0); PG8_BAR; PG8_MMA(1, 0, At, B0); PG8_MMA(1, 1, At, B1); PG8_BAR; PG8_SCHED;
        }
        if (wr == 0) PG8_BAR;
        const bool keep = E(acc, cur, wr, wc, fr, fq);
        __builtin_amdgcn_s_waitcnt(0x0F70);
        if (!has_next) break;
        if (!keep) {
#pragma unroll
            for (int a = 0; a < 2; ++a)
#pragma unroll
                for (int b = 0; b < 2; ++b)
#pragma unroll
                    for (int m = 0; m < 4; ++m)
#pragma unroll
                        for (int n = 0; n < 2; ++n) acc[a][b][m][n] = (f32x4){0.f, 0.f, 0.f, 0.f};
        }
        cur = nxt; cA = nA; cB = nB; ++ui;
        if (wr == 1) PG8_BAR;
    }
    PG8_WAIT_V(0);
    PG8_BAR;
#undef PG8_SA
#undef PG8_SB
#undef PG8_STAGE
#undef PG8_LDA
#undef PG8_DSR
#undef PG8_LDB
#undef PG8_MMA
#undef PG8_WAIT_V
#undef PG8_WAIT_L
#undef PG8_BAR
#undef PG8_SCHED
}
}
using pg8::Unit;

__device__ __forceinline__ u32x4 pack8(const f32x4 a, const f32x4 b) { u32x4 w; w.x = cvt_pk_bf16(a[0], a[1]); w.y = cvt_pk_bf16(a[2], a[3]); w.z = cvt_pk_bf16(b[0], b[1]); w.w = cvt_pk_bf16(b[2], b[3]); return w; }

struct EpiInProj {
    bf16_t *Q, *Kb, *Vb, *CB, *U, *RHO, *SC; const float* rope;
    __device__ __forceinline__ bool operator()(f32x4 (&acc)[2][2][4][2], const Unit& u, int wr, int wc, int fr, int fq) const {
        const int row0 = u.pm * 256 + wr * 64 + fr, pn = u.pn, cw = wc * 32 + fq * 8;
        if (pn <= 8) {
            bf16_t* dst = pn < 8 ? Q : Kb; const int ld = pn < 8 ? D : 256; const int cbase = pn < 8 ? pn * 256 : 0; const float sc = pn < 8 ? QSCALE : 1.0f;
            const bool lat = u.pm < 64;
#pragma unroll
            for (int ai = 0; ai < 2; ++ai) {
                f32x4 cvv[4], svv[4];
#pragma unroll
                for (int m = 0; m < 4; ++m) {
                    const int row = row0 + ai * 128 + m * 16; const int t = row & (SEQ - 1);
                    const int pos = (wc & 1) ? (t & 63) : (t >> 6);
                    cvv[m] = (f32x4){1.f, 1.f, 1.f, 1.f}; svv[m] = (f32x4){0.f, 0.f, 0.f, 0.f};
                    if (lat) { cvv[m] = *(const f32x4*)(rope + pos * 16 + 4 * fq); svv[m] = *(const f32x4*)(rope + 2048 + pos * 16 + 4 * fq); }
                }
                __builtin_amdgcn_sched_barrier(0);
#pragma unroll
                for (int m = 0; m < 4; ++m) {
                    const int row = row0 + ai * 128 + m * 16; const f32x4 cv = cvv[m], sv = svv[m];
#pragma unroll
                    for (int bj = 0; bj < 2; ++bj) {
                        const f32x4 x1 = acc[ai][bj][m][0], x2 = acc[ai][bj][m][1];
                        const f32x4 y1 = (x1 * cv - x2 * sv) * sc, y2 = (x2 * cv + x1 * sv) * sc;
                        *(u32x4*)(dst + (size_t)row * ld + cbase + bj * 128 + cw) = pack8(y1, y2);
                    }
                }
                __builtin_amdgcn_sched_barrier(0);
            }
        } else if (pn <= 17) {
            bf16_t* dst = pn == 9 ? Vb : CB; const int ld = pn == 9 ? 256 : D; const int cbase = pn == 9 ? 0 : (pn - 10) * 256;
#pragma unroll
            for (int ai = 0; ai < 2; ++ai)
#pragma unroll
                for (int m = 0; m < 4; ++m) {
                    const int row = row0 + ai * 128 + m * 16;
#pragma unroll
                    for (int bj = 0; bj < 2; ++bj) *(u32x4*)(dst + (size_t)row * ld + cbase + bj * 128 + cw) = pack8(acc[ai][bj][m][0], acc[ai][bj][m][1]);
                }
        } else if (pn <= 33) {
            const int cbase = (pn - 18) * 128 + cw;
#pragma unroll
            for (int ai = 0; ai < 2; ++ai)
#pragma unroll
                for (int m = 0; m < 4; ++m) {
                    const int row = row0 + ai * 128 + m * 16;
                    *(u32x4*)(U + (size_t)row * D + cbase) = pack8(acc[ai][0][m][0] * acc[ai][1][m][0], acc[ai][0][m][1] * acc[ai][1][m][1]);
                }
        } else {
            const int cbase = (pn - 34) * 128 + cw;
#pragma unroll
            for (int ai = 0; ai < 2; ++ai)
#pragma unroll
                for (int m = 0; m < 4; ++m) {
                    const int row = row0 + ai * 128 + m * 16;
                    f32x4 r0, r1, s0, s1;
#pragma unroll
                    for (int j = 0; j < 4; ++j) {
                        const float ea0 = __builtin_amdgcn_exp2f(-acc[ai][0][m][0][j] * LOG2E), ea1 = __builtin_amdgcn_exp2f(-acc[ai][0][m][1][j] * LOG2E);
                        const float ec0 = __builtin_amdgcn_exp2f(-acc[ai][1][m][0][j] * LOG2E), ec1 = __builtin_amdgcn_exp2f(-acc[ai][1][m][1][j] * LOG2E);
                        s0[j] = __builtin_amdgcn_rcpf(1.0f + ec0); s1[j] = __builtin_amdgcn_rcpf(1.0f + ec1);
                        r0[j] = (1.0f + ec0) * __builtin_amdgcn_rcpf(1.0f + ea0); r1[j] = (1.0f + ec1) * __builtin_amdgcn_rcpf(1.0f + ea1);
                    }
                    *(u32x4*)(RHO + (size_t)row * D + cbase) = pack8(r0, r1);
                    *(u32x4*)(SC + (size_t)row * D + cbase) = pack8(s0, s1);
                }
        }
        return false;
    }
};

struct EpiMerge {
    const bf16_t *RHO, *SC; bf16_t* Mo; float* part;
    __device__ __forceinline__ bool operator()(f32x4 (&acc)[2][2][4][2], const Unit& u, int wr, int wc, int fr, int fq) const {
        const int row0 = u.pm * 256 + wr * 64 + fr, c0 = u.pn * 256 + wc * 32 + fq * 8;
        const bf16_t* G = u.src == 0 ? RHO : SC;
        float* pd = part + (size_t)u.src * MC * D - (size_t)ML * D;
#pragma unroll
        for (int b4 = 0; b4 < 4; ++b4) {
            const int ai = b4 >> 1, mh = (b4 & 1) * 2;
            u32x4 gq[2][2];
#pragma unroll
            for (int mm = 0; mm < 2; ++mm)
#pragma unroll
                for (int bj = 0; bj < 2; ++bj) { const size_t ro = (size_t)(row0 + ai * 128 + (mh + mm) * 16) * D + c0 + bj * 128;
                    gq[mm][bj] = *(const u32x4*)(G + ro); }
            __builtin_amdgcn_sched_barrier(0);
#pragma unroll
            for (int mm = 0; mm < 2; ++mm)
#pragma unroll
                for (int bj = 0; bj < 2; ++bj) { const size_t ro = (size_t)(row0 + ai * 128 + (mh + mm) * 16) * D + c0 + bj * 128; const int m = mh + mm;
                    const u32x4 g = gq[mm][bj];
                    f32x4 g0 = (f32x4){bf_lo(g.x), bf_hi(g.x), bf_lo(g.y), bf_hi(g.y)}, g1 = (f32x4){bf_lo(g.z), bf_hi(g.z), bf_lo(g.w), bf_hi(g.w)};
                    if (u.src == 4) { const u32x4 r = *(const u32x4*)(RHO + ro);
                        g0 *= (f32x4){bf_lo(r.x), bf_hi(r.x), bf_lo(r.y), bf_hi(r.y)}; g1 *= (f32x4){bf_lo(r.z), bf_hi(r.z), bf_lo(r.w), bf_hi(r.w)}; }
                    acc[ai][bj][m][0] *= g0; acc[ai][bj][m][1] *= g1;
                    if (u.src == 1) *(u32x4*)(Mo + ro) = pack8(acc[ai][bj][m][0], acc[ai][bj][m][1]);
                    if (u.src >= 4) { *(f32x4*)(pd + ro) = acc[ai][bj][m][0]; *(f32x4*)(pd + ro + 4) = acc[ai][bj][m][1]; }
                }
            __builtin_amdgcn_sched_barrier(0);
        }
        return u.src == 0;
    }
};

struct EpiResid {
    bf16_t* xb; const float* gate; float* part;
    __device__ __forceinline__ bool operator()(f32x4 (&acc)[2][2][4][2], const Unit& u, int wr, int wc, int fr, int fq) const {
        if (u.src >= 2) {
            float* pd = part + (size_t)(u.src - 2) * MC * D + (size_t)((u.pm - 64) * 256 + wr * 64 + fr) * D + u.pn * 256 + wc * 32 + fq * 8;
#pragma unroll
            for (int ai = 0; ai < 2; ++ai)
#pragma unroll
                for (int m = 0; m < 4; ++m)
#pragma unroll
                    for (int bj = 0; bj < 2; ++bj) { float* q = pd + (size_t)(ai * 128 + m * 16) * D + bj * 128; *(f32x4*)q = acc[ai][bj][m][0]; *(f32x4*)(q + 4) = acc[ai][bj][m][1]; }
            return false;
        }
        const int vec = u.pm >> 5;
        const int row0 = u.pm * 256 + wr * 64 + fr, c0 = u.pn * 256 + wc * 32 + fq * 8;
        const float* gp = gate + vec * 12288 + c0;
        f32x4 gv[2][2];
#pragma unroll
        for (int bj = 0; bj < 2; ++bj) { gv[bj][0] = *(const f32x4*)(gp + bj * 128); gv[bj][1] = *(const f32x4*)(gp + bj * 128 + 4); }
#pragma unroll
        for (int b4 = 0; b4 < 4; ++b4) {
            const int ai = b4 >> 1, mh = (b4 & 1) * 2;
            u32x4 xq[2][2];
#pragma unroll
            for (int mm = 0; mm < 2; ++mm)
#pragma unroll
                for (int bj = 0; bj < 2; ++bj) xq[mm][bj] = *(const u32x4*)(xb + (size_t)(row0 + ai * 128 + (mh + mm) * 16) * D + c0 + bj * 128);
            __builtin_amdgcn_sched_barrier(0);
#pragma unroll
            for (int mm = 0; mm < 2; ++mm)
#pragma unroll
                for (int bj = 0; bj < 2; ++bj)
                { const u32x4 q = xq[mm][bj]; const f32x4 x0 = (f32x4){bf_lo(q.x), bf_hi(q.x), bf_lo(q.y), bf_hi(q.y)}, x1 = (f32x4){bf_lo(q.z), bf_hi(q.z), bf_lo(q.w), bf_hi(q.w)};
                    *(u32x4*)(xb + (size_t)(row0 + ai * 128 + (mh + mm) * 16) * D + c0 + bj * 128) = pack8(x0 + gv[bj][0] * acc[ai][bj][mh + mm][0], x1 + gv[bj][1] * acc[ai][bj][mh + mm][1]); }
            __builtin_amdgcn_sched_barrier(0);
        }
        return false;
    }
};

struct EpiSwiglu {
    bf16_t* HID;
    __device__ __forceinline__ bool operator()(f32x4 (&acc)[2][2][4][2], const Unit& u, int wr, int wc, int fr, int fq) const {
        const int row0 = u.pm * 256 + wr * 64 + fr, c0 = u.pn * 128 + wc * 32 + fq * 8;
#pragma unroll
        for (int ai = 0; ai < 2; ++ai)
#pragma unroll
            for (int m = 0; m < 4; ++m) {
                f32x4 h0, h1;
#pragma unroll
                for (int j = 0; j < 4; ++j) {
                    const float g0 = acc[ai][0][m][0][j], g1 = acc[ai][0][m][1][j];
                    h0[j] = g0 * fast_sigmoid(g0) * acc[ai][1][m][0][j]; h1[j] = g1 * fast_sigmoid(g1) * acc[ai][1][m][1][j];
                }
                *(u32x4*)(HID + (size_t)(row0 + ai * 128 + m * 16) * DFF + c0) = pack8(h0, h1);
            }
        return false;
    }
};

struct Args {
    const float* in[18]; float* out; unsigned char* ws; int ph_lo, ph_hi;
};

__device__ __forceinline__ int src_group_base(int kind, int n0, bool& ropeperm) {
    ropeperm = false;
    if (kind == 0) return n0;
    const int pn = n0 >> 8, off = n0 & 255;
    if (kind == 1) {
        if (pn <= 8) { ropeperm = true; return n0; }
        if (pn <= 17) return n0;
        if (pn <= 33) { const int j = pn - 18; return off < 128 ? OFF_CC + 128 * j + off : OFF_CX + 128 * j + off - 128; }
        const int j = pn - 34; return off < 128 ? OFF_GA + 128 * j + off : OFF_GC + 128 * j + off - 128;
    }
    return off < 128 ? 128 * pn + off : DFF + 128 * pn + off - 128;
}
__device__ __forceinline__ void transpose_item(const float* W, int K, int N, int NP, int kind, bf16_t* WT, LAS float* scr, int item, int lane) {
    const int nblk = NP / 32, kb = item / nblk, nb = item % nblk, k0 = 64 * kb, n0 = 32 * nb;
    bool rp; const int sb = src_group_base(kind, n0, rp);
    const int p = lane & 31; const int so = rp ? (4 * (p >> 3) + (p & 3) + 16 * ((p >> 2) & 1)) : p;
#pragma unroll 8
    for (int i = 0; i < 32; ++i) { const int kk = 2 * i + (lane >> 5); scr[kk * 33 + p] = W[(size_t)(k0 + kk) * N + sb + so]; }
    asm volatile("s_waitcnt lgkmcnt(0)" ::: "memory");
    const int c = lane & 7;
#pragma unroll
    for (int j = 0; j < 4; ++j) { const int n = (lane >> 3) + 8 * j; const LAS float* s = scr + (8 * c) * 33 + n;
        u32x4 o; o.x = cvt_pk_bf16(s[0 * 33], s[1 * 33]); o.y = cvt_pk_bf16(s[2 * 33], s[3 * 33]); o.z = cvt_pk_bf16(s[4 * 33], s[5 * 33]); o.w = cvt_pk_bf16(s[6 * 33], s[7 * 33]);
        *(u32x4*)(WT + (size_t)(n0 + n) * K + k0 + 8 * c) = o; }
    asm volatile("s_waitcnt lgkmcnt(0)" ::: "memory");
}

__device__ __forceinline__ void sincos_f32(float ang, float& sn, float& cs) {
    const float k = rintf(ang * 0.15915494309189535f);
    float r = fmaf(-k, 6.28125f, ang); r = fmaf(-k, 1.935307179586232e-3f, r);
    const float r2 = r * r;
    float ps = -1.0f / 51090942171709440000.0f;
    ps = fmaf(ps, r2, 1.0f / 121645100408832000.0f); ps = fmaf(ps, r2, -1.0f / 355687428096000.0f); ps = fmaf(ps, r2, 1.0f / 1307674368000.0f);
    ps = fmaf(ps, r2, -1.0f / 6227020800.0f); ps = fmaf(ps, r2, 1.0f / 39916800.0f); ps = fmaf(ps, r2, -1.0f / 362880.0f); ps = fmaf(ps, r2, 1.0f / 5040.0f);
    ps = fmaf(ps, r2, -1.0f / 120.0f); ps = fmaf(ps, r2, 1.0f / 6.0f); sn = fmaf(-r * r2, ps, r);
    float pc = 1.0f / 2432902008176640000.0f;
    pc = fmaf(pc, r2, -1.0f / 6402373705728000.0f); pc = fmaf(pc, r2, 1.0f / 20922789888000.0f); pc = fmaf(pc, r2, -1.0f / 87178291200.0f); pc = fmaf(pc, r2, 1.0f / 479001600.0f);
    pc = fmaf(pc, r2, -1.0f / 3628800.0f); pc = fmaf(pc, r2, 1.0f / 40320.0f); pc = fmaf(pc, r2, -1.0f / 720.0f); pc = fmaf(pc, r2, 1.0f / 24.0f); pc = fmaf(pc, r2, -0.5f);
    cs = fmaf(pc, r2, 1.0f);
}

constexpr int KSTR = 144, VSTR = 192;
constexpr int ATT_K = 0, ATT_V = 2 * 64 * KSTR;
__device__ __forceinline__ s16x4 vtr(const LAS unsigned char* p) { return __builtin_bit_cast(s16x4, __builtin_amdgcn_ds_read_tr16_b64_v4i16((LAS s16x4*)p)); }

__device__ __forceinline__ void attn_unit(LAS unsigned char* lds, const bf16_t* Q, const bf16_t* Kb, const bf16_t* Vb, bf16_t* O, const float* sink,
                                          int qrow0, int kvh, int crow0, int lrow0, int jlo, int jhi, int qpos0, const int wave_s) {
    int tid = tid_of(wave_s); asm volatile("" : "+v"(tid));
    const int wid = __builtin_amdgcn_readfirstlane(tid >> 6), lane = tid & 63, l31 = lane & 31, h = lane >> 5;
    const int head = kvh * 8 + wid;
    const int ntile = 4 + (jhi - jlo + 1);
    bf16x8 Qf[2][4];
#pragma unroll
    for (int qs = 0; qs < 2; ++qs)
#pragma unroll
        for (int ks = 0; ks < 4; ++ks) Qf[qs][ks] = *(const bf16x8*)(Q + (size_t)(qrow0 + 32 * qs + l31) * D + head * 64 + 16 * ks + 8 * h);
    const float sk = sink[head] * LOG2E;
    float mrow[2] = {sk, sk}, lsum[2] = {h == 0 ? 1.0f : 0.0f, h == 0 ? 1.0f : 0.0f};
    f32x16 Oacc[2][2];
#pragma unroll
    for (int qs = 0; qs < 2; ++qs)
#pragma unroll
        for (int dh = 0; dh < 2; ++dh)
#pragma unroll
            for (int r = 0; r < 16; ++r) Oacc[qs][dh][r] = 0.f;
    const int skey = tid >> 3, sch = tid & 7;
    const size_t gcol = (size_t)kvh * 64 + sch * 8;
    u32x4 kreg, vreg;
    { const int rb = crow0; kreg = *(const u32x4*)(Kb + (size_t)(rb + skey) * 256 + gcol); vreg = *(const u32x4*)(Vb + (size_t)(rb + skey) * 256 + gcol); }
    for (int ti = 0; ti < ntile; ++ti) {
        LAS unsigned char* kb = lds + ATT_K + (ti & 1) * 64 * KSTR; LAS unsigned char* vb = lds + ATT_V + (ti & 1) * 64 * VSTR;
        *(LAS u32x4*)(kb + skey * KSTR + sch * 16) = kreg; *(LAS u32x4*)(vb + skey * VSTR + sch * 16) = vreg;
        __syncthreads();
        if (ti + 1 < ntile) { const int tn = ti + 1; const int rb = tn < 4 ? crow0 + 64 * tn : lrow0 + 64 * (jlo + tn - 4);
            kreg = *(const u32x4*)(Kb + (size_t)(rb + skey) * 256 + gcol); vreg = *(const u32x4*)(Vb + (size_t)(rb + skey) * 256 + gcol); }
        const int jl = ti < 4 ? -1 : jlo + ti - 4;
        const bool masked = (jl == 0) || (jl == 4);
        const int kp0 = qpos0 - 128 + 64 * jl;
        bf16x8 Kf[2][4];
#pragma unroll
        for (int kt = 0; kt < 2; ++kt)
#pragma unroll
            for (int ks = 0; ks < 4; ++ks) Kf[kt][ks] = *(const LAS bf16x8*)(kb + (32 * kt + l31) * KSTR + (16 * ks + 8 * h) * 2);
#pragma unroll
        for (int qs = 0; qs < 2; ++qs) {
            f32x16 S[2];
#pragma unroll
            for (int kt = 0; kt < 2; ++kt) {
#pragma unroll
                for (int r = 0; r < 16; ++r) S[kt][r] = 0.f;
#pragma unroll
                for (int ks = 0; ks < 4; ++ks) S[kt] = __builtin_amdgcn_mfma_f32_32x32x16_bf16(Kf[kt][ks], Qf[qs][ks], S[kt], 0, 0, 0);
            }
            if (masked) {
                const int qp = qpos0 + 32 * qs + l31;
#pragma unroll
                for (int kt = 0; kt < 2; ++kt)
#pragma unroll
                    for (int r = 0; r < 16; ++r) { const int dlt = kp0 + 32 * kt + (r & 3) + 8 * (r >> 2) + 4 * h - qp; if (dlt > 128 || dlt < -128) S[kt][r] = -INFINITY; }
            }
            float mx = S[0][0];
#pragma unroll
            for (int kt = 0; kt < 2; ++kt)
#pragma unroll
                for (int r = 0; r < 16; ++r) mx = fmaxf(mx, S[kt][r]);
            mx = fmaxf(mx, xor_lane(mx, lane, 32));
            const float mnew = fmaxf(mrow[qs], mx);
            const float alpha = __builtin_amdgcn_exp2f(mrow[qs] - mnew);
            mrow[qs] = mnew;
            float ps = 0.f;
#pragma unroll
            for (int kt = 0; kt < 2; ++kt)
#pragma unroll
                for (int r = 0; r < 16; ++r) { S[kt][r] = __builtin_amdgcn_exp2f(S[kt][r] - mnew); ps += S[kt][r]; }
            lsum[qs] = lsum[qs] * alpha + ps;
#pragma unroll
            for (int dh = 0; dh < 2; ++dh)
#pragma unroll
                for (int r = 0; r < 16; ++r) Oacc[qs][dh][r] *= alpha;
#pragma unroll
            for (int s = 0; s < 4; ++s) {
                const int kt = s >> 1, sp = s & 1;
                u32x4 pw; pw.x = cvt_pk_bf16(S[kt][8 * sp + 0], S[kt][8 * sp + 1]); pw.y = cvt_pk_bf16(S[kt][8 * sp + 2], S[kt][8 * sp + 3]);
                pw.z = cvt_pk_bf16(S[kt][8 * sp + 4], S[kt][8 * sp + 5]); pw.w = cvt_pk_bf16(S[kt][8 * sp + 6], S[kt][8 * sp + 7]);
                const bf16x8 Pf = __builtin_bit_cast(bf16x8, pw);
#pragma unroll
                for (int dh = 0; dh < 2; ++dh) {
                    const int g1 = (lane >> 4) & 1, li = lane & 15, q4 = li >> 2, p4 = li & 3;
                    const LAS unsigned char* va = vb + (16 * s + 4 * h + q4) * VSTR + (32 * dh + 16 * g1 + 4 * p4) * 2;
                    const s16x4 lo = vtr(va), hi = vtr(va + 8 * VSTR);
                    const bf16x8 Vf = (bf16x8){lo[0], lo[1], lo[2], lo[3], hi[0], hi[1], hi[2], hi[3]};
                    Oacc[qs][dh] = __builtin_amdgcn_mfma_f32_32x32x16_bf16(Vf, Pf, Oacc[qs][dh], 0, 0, 0);
                }
            }
        }
    }
#pragma unroll
    for (int qs = 0; qs < 2; ++qs) {
        const float lt = lsum[qs] + xor_lane(lsum[qs], lane, 32);
        const float inv = 1.0f / lt;
        bf16_t* orow = O + (size_t)(qrow0 + 32 * qs + l31) * D + head * 64;
#pragma unroll
        for (int dh = 0; dh < 2; ++dh)
#pragma unroll
            for (int rg = 0; rg < 4; ++rg) {
                u32x2 w; w.x = cvt_pk_bf16(Oacc[qs][dh][4 * rg + 0] * inv, Oacc[qs][dh][4 * rg + 1] * inv); w.y = cvt_pk_bf16(Oacc[qs][dh][4 * rg + 2] * inv, Oacc[qs][dh][4 * rg + 3] * inv);
                *(u32x2*)(orow + 32 * dh + 8 * rg + 4 * h) = w;
            }
    }
    __syncthreads();
}


#define XB_TMO      128
#define XB_XCNT(j)  (256  + 64 * (j))
#define XB_XSUB(j)  (1280 + 64 * (j))
#define XB_XGEN(j)  (2304 + 64 * (j))
#define XB_TOP      3328
#define XB_TOPGEN   3392
#define XCD_BAR_WORDS 3456
#define XB_SPIN_CAP (1u << 18)
__device__ __forceinline__ unsigned xb_ld(unsigned* p)              { return __hip_atomic_load(p, __ATOMIC_RELAXED, __HIP_MEMORY_SCOPE_AGENT); }
__device__ __forceinline__ unsigned xb_add(unsigned* p, unsigned v) { return __hip_atomic_fetch_add(p, v, __ATOMIC_RELAXED, __HIP_MEMORY_SCOPE_AGENT); }
__device__ __forceinline__ unsigned xb_xcc_id() { return (unsigned)__builtin_amdgcn_s_getreg((3 << 11) | 20) & 0xFu; }
#define XB_SPIN(cond, bar) do { unsigned _sp = 0; while (cond) { __builtin_amdgcn_s_sleep(1); \
    if ((++_sp & 255u) == 0u) { if (xb_ld(&(bar)[XB_TMO])) break; if (_sp > XB_SPIN_CAP) { atomicAdd(&(bar)[XB_TMO], 1u); break; } } } } while (0)
struct XcdBarrier { unsigned* bar; unsigned x; volatile LAS unsigned* st; };
__device__ __forceinline__ XcdBarrier xcd_barrier_post(unsigned* bar, volatile LAS unsigned* st, const int wave_s) {
    XcdBarrier b; b.bar = bar; b.x = xb_xcc_id(); b.st = st;
    if (tid_of(wave_s) == 0) (void)xb_add(&bar[XB_XCNT(b.x)], 1u);
    return b;
}
__device__ __forceinline__ void xcd_barrier_complete(unsigned* bar, unsigned x, unsigned& nloc, unsigned& nx) {
    const unsigned G = gridDim.x * gridDim.y * gridDim.z;
    unsigned sum, cnt, mine, sp = 0u;
    for (;;) {
        sum = 0u; cnt = 0u; mine = 0u;
#pragma unroll
        for (unsigned j = 0; j < 16; ++j) { const unsigned c = xb_ld(&bar[XB_XCNT(j)]); sum += c; cnt += (c > 0u) ? 1u : 0u; mine = (j == x) ? c : mine; }
        if (sum == G) break;
        __builtin_amdgcn_s_sleep(1);
        if ((++sp & 255u) == 0u) { if (xb_ld(&bar[XB_TMO])) break; if (sp > XB_SPIN_CAP) { atomicAdd(&bar[XB_TMO], 1u); break; } }
    }
    nloc = mine > 0u ? mine : 1u; nx = cnt > 0u ? cnt : 1u;
}
__device__ __forceinline__ void xcd_barrier(const XcdBarrier& b, const int wave_s) {
    asm volatile("s_waitcnt vmcnt(0)" ::: "memory");
    __syncthreads();
    if (tid_of(wave_s) == 0) {
        unsigned* bar = b.bar;
        __builtin_amdgcn_s_waitcnt(0);
        unsigned nloc = b.st[0], nx = b.st[1];
        if (nloc == 0u) { xcd_barrier_complete(bar, b.x, nloc, nx); b.st[0] = nloc; b.st[1] = nx; }
        const unsigned old = xb_add(&bar[XB_XSUB(b.x)], 1u);
        const unsigned gen = old / nloc;
        if (old + 1u == (gen + 1u) * nloc) {
            __builtin_amdgcn_fence(__ATOMIC_RELEASE, "agent");
            asm volatile("s_waitcnt vmcnt(0)" ::: "memory");
            const unsigned og = xb_add(&bar[XB_TOP], 1u);
            const unsigned tg = og / nx;
            if (og + 1u == (tg + 1u) * nx) xb_add(&bar[XB_TOPGEN], 1u);
            else XB_SPIN(xb_ld(&bar[XB_TOPGEN]) == tg, bar);
            __builtin_amdgcn_fence(__ATOMIC_ACQUIRE, "agent");
            xb_add(&bar[XB_XGEN(b.x)], 1u);
            asm volatile("s_waitcnt vmcnt(0)" ::: "memory");
        } else {
            XB_SPIN(xb_ld(&bar[XB_XGEN(b.x)]) == gen, bar);
            __builtin_amdgcn_fence(__ATOMIC_ACQUIRE, "agent");
            asm volatile("s_waitcnt vmcnt(0)" ::: "memory");
        }
    }
    __syncthreads();
}

constexpr int LDS_BYTES = 147456;
constexpr int NPHASE = 18;


#define x_in      (a.in[0])
#define c_in      (a.in[1])
#define ctx_in    (a.in[2])
#define cctx_in   (a.in[3])
#define ada_w     (a.in[4])
#define ada_b     (a.in[5])
#define norm1_g   (a.in[6])
#define norm2_g   (a.in[7])
#define w_in      (a.in[8])
#define conv_w    (a.in[9])
#define conv_b    (a.in[10])
#define sink      (a.in[11])
#define w_attn_out (a.in[12])
#define w_conv_out (a.in[13])
#define w_o       (a.in[14])
#define w_ffn_in  (a.in[15])
#define w_ffn_out (a.in[16])
#define final_g   (a.in[17])
#define out       (a.out)
#define ws        (a.ws)
#define ADA  ((float*)(ws + WS_ADA))
#define ROPE ((float*)(ws + WS_ROPE))
#define XC   ((float*)(ws + WS_XC))
#define Hb   ((bf16_t*)(ws + WS_H))
#define Qb   ((bf16_t*)(ws + WS_Q))
#define CBb  ((bf16_t*)(ws + WS_CB))
#define Ub   ((bf16_t*)(ws + WS_U))
#define RHOb ((bf16_t*)(ws + WS_RHO))
#define SCb  ((bf16_t*)(ws + WS_SC))
#define Kb   ((bf16_t*)(ws + WS_K))
#define Vb   ((bf16_t*)(ws + WS_V))
#define HIDb ((bf16_t*)(ws + WS_HID))
#define Mb   Ub
#define PARTb ((float*)(ws + WS_PART))
#define MPARTb ((float*)(ws + WS_MPART) - (size_t)4 * MC * D)
#define XBb  ((bf16_t*)(ws + WS_XB))
__global__ void __launch_bounds__(512, 2) fwd_kernel(const Args a) {
    extern __shared__ __attribute__((aligned(16))) unsigned char lds_raw[];
    LAS unsigned char* lds = (LAS unsigned char*)lds_raw;
    cg::grid_group grid = cg::this_grid();
    const int G = gridDim.x, bx = blockIdx.x;
    volatile LAS unsigned* lctl = (volatile LAS unsigned*)(lds + 131072);
    const int wave_s = __builtin_amdgcn_readfirstlane((int)threadIdx.x >> 6);
    if (tid_of(wave_s) < 16) lctl[tid_of(wave_s)] = 0u;
    __syncthreads();
    const XcdBarrier xbar = xcd_barrier_post((unsigned*)ws + 4096, lctl + 8, wave_s);
    for (int ph = a.ph_lo; ph < a.ph_hi; ++ph) {
        int tid = tid_of(wave_s); asm volatile("" : "+v"(tid));
        const int lane = tid & 63, wave = wave_s;
        const int gw = bx * 8 + wave, NGW = G * 8;
        if (ph == 0) {
          for (int rep = 0; rep < REP_P0; ++rep) {
            LAS float* scr = (LAS float*)(lds + wave * 16384);
            constexpr int I_IN = 32 * (NIN / 32), I_SQ = 32 * 64, I_F1 = 32 * (NF1 / 32), I_F2 = (DFF / 64) * 64, I_L = I_IN + 3 * I_SQ + I_F1 + I_F2;
            for (int it = gw; it < DEPTH * I_L; it += NGW) {
                const int l = it / I_L; int r = it % I_L; unsigned char* wl = ws + WS_W + (size_t)l * W_LAYER;
                if (r < I_IN) { transpose_item(w_in + (size_t)l * D * NIN, D, NIN, NIN, 1, (bf16_t*)(wl + W_IN), scr, r, lane); continue; } r -= I_IN;
                if (r < I_SQ) { transpose_item(w_attn_out + (size_t)l * D * D, D, D, D, 0, (bf16_t*)(wl + W_A), scr, r, lane); continue; } r -= I_SQ;
                if (r < I_SQ) { transpose_item(w_conv_out + (size_t)l * D * D, D, D, D, 0, (bf16_t*)(wl + W_C), scr, r, lane); continue; } r -= I_SQ;
                if (r < I_SQ) { transpose_item(w_o + (size_t)l * D * D, D, D, D, 0, (bf16_t*)(wl + W_O), scr, r, lane); continue; } r -= I_SQ;
                if (r < I_F1) { transpose_item(w_ffn_in + (size_t)l * D * NF1, D, NF1, NF1, 2, (bf16_t*)(wl + W_F1), scr, r, lane); continue; } r -= I_F1;
                transpose_item(w_ffn_out + (size_t)l * DFF * D, DFF, D, D, 0, (bf16_t*)(wl + W_F2), scr, r, lane);
            }
            __syncthreads();
            LAS float* sl = (LAS float*)lds;
            LAS float* red = (LAS float*)(lds + 3 * 2048 * 4);
            for (int i = tid; i < 3 * 2048; i += 512) { const int v = i >> 11, k = i & 2047; const float cv = v < 2 ? c_in[v * 2048 + k] : cctx_in[k]; sl[i] = cv / (1.0f + __expf(-cv)); }
            __syncthreads();
            for (int it = bx; it < DEPTH * 192; it += G) {
                const int l = it / 192, j0 = (it % 192) * 64;
                const float* wp = ada_w + (size_t)l * D * 12288 + (size_t)(wave * 256) * 12288 + j0 + lane;
                float a0 = 0.f, a1 = 0.f, a2 = 0.f;
#pragma unroll 8
                for (int k = 0; k < 256; ++k) { const float w = wp[(size_t)k * 12288]; const int kk = wave * 256 + k; a0 += sl[kk] * w; a1 += sl[2048 + kk] * w; a2 += sl[4096 + kk] * w; }
                red[(wave * 3 + 0) * 64 + lane] = a0; red[(wave * 3 + 1) * 64 + lane] = a1; red[(wave * 3 + 2) * 64 + lane] = a2;
                __syncthreads();
                if (tid < 192) { const int v = tid >> 6, jl = tid & 63; float s = ada_b[l * 12288 + j0 + jl];
#pragma unroll
                    for (int w8 = 0; w8 < 8; ++w8) s += red[(w8 * 3 + v) * 64 + jl];
                    ADA[(l * 3 + v) * 12288 + j0 + jl] = s; }
                __syncthreads();
            }
            if (bx == (G > 1 ? 1 : 0)) {
                for (int i = tid; i < 2048; i += 512) { const int pos = i >> 4, f = i & 15;
                    float fq_;
                    switch (f) { case 0: fq_ = 1.f; break; case 1: fq_ = 0.562341325f; break; case 2: fq_ = 0.316227766f; break; case 3: fq_ = 0.177827941f; break;
                        case 4: fq_ = 0.1f; break; case 5: fq_ = 0.0562341325f; break; case 6: fq_ = 0.0316227766f; break; case 7: fq_ = 0.0177827941f; break;
                        case 8: fq_ = 0.01f; break; case 9: fq_ = 0.00562341325f; break; case 10: fq_ = 0.00316227766f; break; case 11: fq_ = 0.00177827941f; break;
                        case 12: fq_ = 0.001f; break; case 13: fq_ = 0.000562341325f; break; case 14: fq_ = 0.000316227766f; break; default: fq_ = 0.000177827941f; break; }
                    float sn, cs; sincos_f32((float)pos * fq_, sn, cs); ROPE[i] = cs; ROPE[2048 + i] = sn; }
            }
          __syncthreads(); }
        } else if (ph == NPHASE - 1) {
            for (int m = gw; m < ML; m += NGW) {
                const u32x2* xq = (const u32x2*)(XBb + (size_t)m * D); f32x4* xr = (f32x4*)(out + (size_t)m * D) + lane; f32x4 v[8]; float ss = 0.f;
#pragma unroll
                for (int j = 0; j < 8; ++j) { const u32x2 q = xq[64 * j + lane]; v[j] = (f32x4){bf_lo(q.x), bf_hi(q.x), bf_lo(q.y), bf_hi(q.y)}; ss += (v[j].x * v[j].x + v[j].y * v[j].y) + (v[j].z * v[j].z + v[j].w * v[j].w); }
                const float rs = rsqrtf(wave_sum(ss, lane) * (1.0f / D) + EPS);
#pragma unroll
                for (int j = 0; j < 8; ++j) { const f32x4 g = ((const f32x4*)final_g)[64 * j + lane]; xr[64 * j] = v[j] * rs * g; }
            }
        } else {
            const int l = (ph - 1) / 8, sp = (ph - 1) % 8;
            unsigned char* wl = ws + WS_W + (size_t)l * W_LAYER;
            const float* ada = ADA + (size_t)l * 3 * 12288;
            const float* xc_cur = l == 0 ? ctx_in : XC;
            if (sp == 0 || sp == 5) {
                const float* xl = x_in; const float* xc = sp == 0 ? xc_cur : XC; const bool lbf = !(sp == 0 && l == 0);
                const float* ng = (sp == 0 ? norm1_g : norm2_g) + l * D; const int so = sp == 0 ? 0 : 3 * 2048;
                const int mend = (sp == 5 && l == DEPTH - 1) ? ML : MT;
                const int nks = (sp == 5 && l == 0) ? 4 : ((sp == 0 && l == 1) ? 11 : 0);
                const float* pgate = ADA + 2 * 12288 + (sp == 5 ? 2 * 2048 : 5 * 2048);
                const float* xcs = (sp == 5 && l == 0) ? ctx_in : xc;
                const int NWC = nks > 4 ? 512 : 256; const bool cw_ = nks > 0 && gw < NWC && NGW > 2 * NWC, lw_ = nks > 0 && !cw_ && NGW > 2 * NWC;
                const int m_beg = cw_ ? ML + gw : (lw_ ? gw - NWC : gw), m_str = cw_ ? NWC : (lw_ ? NGW - NWC : NGW), m_end = cw_ ? MT : (lw_ ? ML : mend);
                for (int rep = 0; rep < REP_NORM; ++rep)
                for (int m = m_beg; m < m_end; m += m_str) {
                    const bool lat = m < ML; const float* xr = lat ? xl + (size_t)m * D : xcs + (size_t)(m - ML) * D; const int vec = lat ? (m >> 13) : 2;
                    const float* shp = ada + vec * 12288 + so; const float* scp = shp + 2048;
                    f32x4 v[8]; float ss = 0.f;
                    if (lat && lbf) { const u32x2* xq = (const u32x2*)(XBb + (size_t)m * D);
#pragma unroll
                        for (int j = 0; j < 8; ++j) { const u32x2 q = xq[64 * j + lane]; v[j] = (f32x4){bf_lo(q.x), bf_hi(q.x), bf_lo(q.y), bf_hi(q.y)}; }
                    } else {
#pragma unroll
                        for (int j = 0; j < 8; ++j) v[j] = ((const f32x4*)xr)[64 * j + lane];
                        if (lat) { u32x2* xw = (u32x2*)(XBb + (size_t)m * D);
#pragma unroll
                            for (int j = 0; j < 8; ++j) { u32x2 w; w.x = cvt_pk_bf16(v[j].x, v[j].y); w.y = cvt_pk_bf16(v[j].z, v[j].w); xw[64 * j + lane] = w; } }
                    }
                    if (!lat && nks > 0) {
                        f32x4 ps[8];
#pragma unroll
                        for (int j = 0; j < 8; ++j) ps[j] = (f32x4){0.f, 0.f, 0.f, 0.f};
#pragma unroll 2
                        for (int kc = 0; kc < nks; ++kc) { const f32x4* pp = (const f32x4*)(PARTb + (size_t)kc * MC * D + (size_t)(m - ML) * D);
#pragma unroll
                            for (int j = 0; j < 8; ++j) ps[j] += pp[64 * j + lane]; }
#pragma unroll
                        for (int j = 0; j < 8; ++j) { v[j] += ((const f32x4*)pgate)[64 * j + lane] * ps[j]; if (sp == 5) ((f32x4*)(XC + (size_t)(m - ML) * D))[64 * j + lane] = v[j]; }
                    }
#pragma unroll
                    for (int j = 0; j < 8; ++j) ss += (v[j].x * v[j].x + v[j].y * v[j].y) + (v[j].z * v[j].z + v[j].w * v[j].w);
                    const float rs = rsqrtf(wave_sum(ss, lane) * (1.0f / D) + EPS);
                    u32x2* o8 = (u32x2*)(Hb + (size_t)m * D) + lane;
#pragma unroll
                    for (int j = 0; j < 8; ++j) { const f32x4 g = ((const f32x4*)ng)[64 * j + lane], sc = ((const f32x4*)scp)[64 * j + lane], sh = ((const f32x4*)shp)[64 * j + lane];
                        const f32x4 y = (v[j] * rs) * g * (sc + 1.0f) + sh; u32x2 w; w.x = cvt_pk_bf16(y.x, y.y); w.y = cvt_pk_bf16(y.z, y.w); o8[64 * j] = w; }
                }
            } else if (sp == 1) {
                pg8::Sched S; S.G = G; S.c = bx; S.mode = 0; S.nN = NIN / 256; S.tstep = (size_t)256 * D * 2; S.ks = 1; S.ntfull = D / 64;
                if (l == DEPTH - 1) { S.nM = 64; S.nwg = 64 * S.nN; S.extra = 4; } else { S.nM = 66; S.nwg = 66 * S.nN; S.extra = 0; }
                S.A0 = S.A1 = (const char*)Hb; S.B0 = S.B1 = (const char*)(wl + W_IN);
                EpiInProj E{Qb, Kb, Vb, CBb, Ub, RHOb, SCb, ROPE};
                for (int rep = 0; rep < REP_INPROJ; ++rep)
                pg8::gemm_phase<D / 64>(lds, D, S, E, wave_s);
            } else if (sp == 2) {
                const int nlat = BATCH * NKV * (SEQ / 64), nctx = (l == DEPTH - 1) ? 0 : BATCH * NKV * (CTXL / 64);
                for (int rep = 0; rep < REP_ATT; ++rep)
                for (int u = bx; u < nlat + nctx; u += G) {
                    if (u < nlat) { const int qb = u % (SEQ / 64), kvh = (u / (SEQ / 64)) % NKV, b = u / ((SEQ / 64) * NKV); const int q0 = qb * 64;
                        const int jlo = q0 >= 128 ? 0 : (q0 >= 64 ? 1 : 2); const int jhi = q0 + 192 <= SEQ ? 4 : (q0 + 128 <= SEQ ? 3 : 2);
                        attn_unit(lds, Qb, Kb, Vb, Hb, sink + l * 32, b * SEQ + q0, kvh, ML + b * CTXL, b * SEQ + q0 - 128, jlo, jhi, q0, wave_s);
                    } else { const int e = u - nlat; const int qb = e % 4, kvh = (e / 4) % NKV, b = e / 16;
                        attn_unit(lds, Qb, Kb, Vb, Hb, sink + l * 32, ML + b * CTXL + qb * 64, kvh, ML + b * CTXL, 0, 0, -1, 0, wave_s); }
                }
                const int mend = (l == DEPTH - 1) ? ML : MT;
                const float* cw = conv_w + l * 3 * D; const float* cbias = conv_b + l * D;
                for (int m = gw; m < mend; m += NGW) {
                    const bool lat = m < ML; const int t = lat ? (m & (SEQ - 1)) : ((m - ML) & (CTXL - 1)); const int tl = lat ? SEQ - 1 : CTXL - 1;
                    const bool hp = t > 0, hn = t < tl;
#pragma unroll
                    for (int j = 0; j < 4; ++j) {
                        const int c0 = (64 * j + lane) * 8; const size_t o = (size_t)m * D + c0;
                        const u32x4 zz = (u32x4){0u, 0u, 0u, 0u};
                        const u32x4 up = hp ? *(const u32x4*)(Ub + o - D) : zz, uc = *(const u32x4*)(Ub + o), un = hn ? *(const u32x4*)(Ub + o + D) : zz, cb = *(const u32x4*)(CBb + o);
                        const f32x4 w0a = *(const f32x4*)(cw + c0), w0b = *(const f32x4*)(cw + c0 + 4), w1a = *(const f32x4*)(cw + D + c0), w1b = *(const f32x4*)(cw + D + c0 + 4);
                        const f32x4 w2a = *(const f32x4*)(cw + 2 * D + c0), w2b = *(const f32x4*)(cw + 2 * D + c0 + 4), ba = *(const f32x4*)(cbias + c0), bb = *(const f32x4*)(cbias + c0 + 4);
#define UNPK_LO(q) ((f32x4){bf_lo(q.x), bf_hi(q.x), bf_lo(q.y), bf_hi(q.y)})
#define UNPK_HI(q) ((f32x4){bf_lo(q.z), bf_hi(q.z), bf_lo(q.w), bf_hi(q.w)})
                        const f32x4 ya = UNPK_LO(cb) * (w0a * UNPK_LO(up) + w1a * UNPK_LO(uc) + w2a * UNPK_LO(un) + ba);
                        const f32x4 yb = UNPK_HI(cb) * (w0b * UNPK_HI(up) + w1b * UNPK_HI(uc) + w2b * UNPK_HI(un) + bb);
#undef UNPK_LO
#undef UNPK_HI
                        *(u32x4*)(CBb + o) = pack8(ya, yb);
                    }
                }
            } else if (sp == 3) {
                pg8::Sched S; S.G = G; S.c = bx; S.mode = 1; S.nN = D / 256; S.tstep = (size_t)256 * D * 2; S.extra = 0; S.ks = 1; S.ntfull = D / 64;
                S.nM = 64; S.nwg = S.nM * S.nN; if (l == 0) S.extra = 32;
                S.A0 = (const char*)Hb; S.A1 = (const char*)CBb; S.B0 = (const char*)(wl + W_A); S.B1 = (const char*)(wl + W_C);
                EpiMerge E{RHOb, SCb, Mb, MPARTb};
                for (int rep = 0; rep < REP_MERGE; ++rep)
                pg8::gemm_phase<D / 64>(lds, D, S, E, wave_s);
            } else if (sp == 4) {
                pg8::Sched S; S.G = G; S.c = bx; S.nN = D / 256; S.tstep = (size_t)256 * D * 2; S.ntfull = D / 64;
                S.nM = 64; S.nwg = S.nM * S.nN; S.ks = 4; S.mode = 0; S.extra = 0;
                S.A0 = S.A1 = (const char*)Mb; S.B0 = S.B1 = (const char*)(wl + W_O);
                EpiResid E{XBb, ada + 2 * 2048, PARTb};
                if (l == 0) {
                    const float* p4 = MPARTb + (size_t)4 * MC * D; const float* p5 = MPARTb + (size_t)5 * MC * D;
                    for (int i = bx * 512 + tid; i < MC * D / 8; i += G * 512) {
                        const f32x4 a0 = *(const f32x4*)(p4 + (size_t)i * 8) + *(const f32x4*)(p5 + (size_t)i * 8), a1 = *(const f32x4*)(p4 + (size_t)i * 8 + 4) + *(const f32x4*)(p5 + (size_t)i * 8 + 4);
                        *(u32x4*)(Mb + (size_t)ML * D + (size_t)i * 8) = pack8(a0, a1); }
                }
                pg8::gemm_phase<D / 64>(lds, D, S, E, wave_s);
                if (l == 0) { xcd_barrier(xbar, wave_s); S.mode = 2; S.nwg = 0; S.extra = 16 * S.ks; S.c = (bx + 128) % G; pg8::gemm_phase<8>(lds, D, S, E, wave_s); }
            } else if (sp == 6) {
                pg8::Sched S; S.G = G; S.c = bx; S.mode = 0; S.nN = NF1 / 256; S.tstep = (size_t)256 * D * 2; S.extra = 0; S.ks = 1; S.ntfull = D / 64;
                S.nM = (l == DEPTH - 1) ? 64 : 66; S.nwg = S.nM * S.nN;
                S.A0 = S.A1 = (const char*)Hb; S.B0 = S.B1 = (const char*)(wl + W_F1);
                EpiSwiglu E{HIDb};
                for (int rep = 0; rep < REP_FFN1; ++rep)
                pg8::gemm_phase<D / 64>(lds, D, S, E, wave_s);
            } else if (sp == 7) {
                pg8::Sched S; S.G = G; S.c = bx; S.nN = D / 256; S.tstep = (size_t)256 * DFF * 2; S.ntfull = DFF / 64;
                S.nM = 64; S.nwg = S.nM * S.nN; S.ks = 11; S.mode = 0; S.extra = 0;
                S.A0 = S.A1 = (const char*)HIDb; S.B0 = S.B1 = (const char*)(wl + W_F2);
                EpiResid E{XBb, ada + 5 * 2048, PARTb};
                pg8::gemm_phase<DFF / 64>(lds, DFF, S, E, wave_s);
                if (l == 0) { S.mode = 2; S.nwg = 0; S.extra = 16 * S.ks; pg8::gemm_phase<8>(lds, DFF, S, E, wave_s); }
            }
        }
        if (ph + 1 < a.ph_hi) for (int rep = 0; rep < REP_SYNC; ++rep) { if (a.ph_hi > 1000) grid.sync(); else xcd_barrier(xbar, wave_s); }
    }
}

#undef x_in
#undef c_in
#undef ctx_in
#undef cctx_in
#undef ada_w
#undef ada_b
#undef norm1_g
#undef norm2_g
#undef w_in
#undef conv_w
#undef conv_b
#undef sink
#undef w_attn_out
#undef w_conv_out
#undef w_o
#undef w_ffn_in
#undef w_ffn_out
#undef final_g
#undef out
#undef ws
#undef ADA
#undef ROPE
#undef XC
#undef Hb
#undef Qb
#undef CBb
#undef Ub
#undef RHOb
#undef SCb
#undef Kb
#undef Vb
#undef HIDb
#undef Mb
#undef PARTb
#undef MPARTb
#undef XBb
extern "C" void kernel_launch(void* const* d_in, const int* in_sizes, int n_in, void* d_out, int out_size, void* d_ws, size_t ws_size, hipStream_t stream) {
    static int grid = 0;
    if (grid == 0) {
        if (n_in != 18 || out_size != ML * D || ws_size < WS_END) { fprintf(stderr, "kernel_launch: unexpected problem (n_in %d, out %d, ws %zu)\n", n_in, out_size, ws_size); grid = -1; return; }
        int dev = 0, cus = 0, per_cu = 0;
        (void)hipGetDevice(&dev); (void)hipDeviceGetAttribute(&cus, hipDeviceAttributeMultiprocessorCount, dev);
        if (hipFuncSetAttribute((const void*)fwd_kernel, hipFuncAttributeMaxDynamicSharedMemorySize, LDS_BYTES) != hipSuccess) { fprintf(stderr, "kernel_launch: hipFuncSetAttribute failed\n"); grid = -1; return; }
        if (hipOccupancyMaxActiveBlocksPerMultiprocessor(&per_cu, (const void*)fwd_kernel, 512, LDS_BYTES) != hipSuccess || per_cu < 1) per_cu = 1;
        (void)hipGetLastError();
        grid = cus * 1;
    }
    if (grid < 0) return;
    (void)hipMemsetAsync(d_ws, 0, 65536, stream);
    Args a{};
    for (int i = 0; i < 18; ++i) a.in[i] = (const float*)d_in[i];
    a.out = (float*)d_out; a.ws = (unsigned char*)d_ws;
#if MK_MULTI
    for (int ph = 0; ph < NPHASE; ++ph) { a.ph_lo = ph; a.ph_hi = ph + 1; if (ph) (void)hipMemsetAsync(d_ws, 0, 65536, stream); hipLaunchKernelGGL(fwd_kernel, dim3(grid), dim3(512), LDS_BYTES, stream, a); }
#else
    a.ph_lo = 0; a.ph_hi = NPHASE;
    void* args[] = {&a};
    hipError_t e = hipLaunchCooperativeKernel((const void*)fwd_kernel, dim3(grid), dim3(512), args, LDS_BYTES, stream);
    if (e != hipSuccess) fprintf(stderr, "cooperative launch failed: %s (grid %d)\n", hipGetErrorString(e), grid);
#endif
}
```

```cpp
#include <hip/hip_runtime.h>
#include <hip/hip_cooperative_groups.h>
#include <cstdio>
#include <cstdint>
namespace cg = cooperative_groups;

#ifndef REP_P0
#define REP_P0 1
#endif
#ifndef REP_ATT
#define REP_ATT 1
#endif
#ifndef REP_NORM
#define REP_NORM 1
#endif
#ifndef REP_INPROJ
#define REP_INPROJ 1
#endif
#ifndef REP_MERGE
#define REP_MERGE 1
#endif
#ifndef REP_FFN1
#define REP_FFN1 1
#endif
#ifndef REP_SYNC
#define REP_SYNC 1
#endif
#ifndef MK_MULTI
#define MK_MULTI 0
#endif

#define LAS __attribute__((address_space(3)))
typedef unsigned short bf16_t;
typedef short bf16x8 __attribute__((ext_vector_type(8)));
typedef short s16x4 __attribute__((ext_vector_type(4)));
typedef float f32x4 __attribute__((ext_vector_type(4)));
typedef float f32x16 __attribute__((ext_vector_type(16)));
typedef unsigned u32x4 __attribute__((ext_vector_type(4)));
typedef unsigned u32x2 __attribute__((ext_vector_type(2)));

constexpr int D = 2048, BATCH = 2, SEQ = 8192, ML = BATCH * SEQ, CTXL = 256, MC = BATCH * CTXL, MT = ML + MC;
constexpr int NKV = 4, HD = 64, DFF = 5632, NIN = 12800, NF1 = 2 * DFF, DEPTH = 2;
constexpr int OFF_CC = 4608, OFF_CX = 6656, OFF_GA = 8704, OFF_GC = 10752;
constexpr float EPS = 1e-6f;
constexpr float QSCALE = 0.125f * 1.4426950408889634f;
constexpr float LOG2E = 1.4426950408889634f;

constexpr size_t MiB = 1u << 20;
constexpr size_t WS_ADA = 1 * MiB;
constexpr size_t WS_ROPE = 1 * MiB + 512 * 1024;
constexpr size_t WS_XC = 2 * MiB;
constexpr size_t WS_W = 8 * MiB;
constexpr size_t W_LAYER = 140 * MiB, W_IN = 0, W_A = 50 * MiB, W_C = 58 * MiB, W_O = 66 * MiB, W_F1 = 74 * MiB, W_F2 = 118 * MiB;
constexpr size_t WS_H = 288 * MiB;
constexpr size_t WS_Q = 354 * MiB;
constexpr size_t WS_CB = 420 * MiB;
constexpr size_t WS_U = 486 * MiB;
constexpr size_t WS_RHO = 552 * MiB;
constexpr size_t WS_SC = 618 * MiB;
constexpr size_t WS_K = 684 * MiB;
constexpr size_t WS_V = 693 * MiB;
constexpr size_t WS_HID = WS_Q;
constexpr size_t WS_PART = WS_RHO;
constexpr size_t WS_MPART = WS_Q;
constexpr size_t WS_XB = 702 * MiB;
constexpr size_t WS_END = 766 * MiB;

__device__ __forceinline__ int lane_id() { return (int)__builtin_amdgcn_mbcnt_hi(~0u, __builtin_amdgcn_mbcnt_lo(~0u, 0u)); }
__device__ __forceinline__ int tid_of(int wave_s) { return (wave_s << 6) | lane_id(); }
__device__ __forceinline__ unsigned cvt_pk_bf16(float lo, float hi) { unsigned r; asm volatile("v_cvt_pk_bf16_f32 %0, %1, %2" : "=v"(r) : "v"(lo), "v"(hi)); return r; }
__device__ __forceinline__ float bf_lo(unsigned u) { return __uint_as_float(u << 16); }
__device__ __forceinline__ float bf_hi(unsigned u) { return __uint_as_float(u & 0xffff0000u); }
__device__ __forceinline__ float xor_lane(float v, int lane, int mask) { return __int_as_float(__builtin_amdgcn_ds_bpermute((lane ^ mask) << 2, __float_as_int(v))); }
__device__ __forceinline__ float wave_sum(float v, int lane) {
#pragma unroll
    for (int o = 1; o < 64; o <<= 1) v += xor_lane(v, lane, o);
    return v;
}
__device__ __forceinline__ float fast_sigmoid(float x) { return __builtin_amdgcn_rcpf(1.0f + __builtin_amdgcn_exp2f(-x * LOG2E)); }

namespace pg8 {
constexpr int BM = 256, BK = 64, HALF = 128, HTB = HALF * BK * 2, STAGE_BYTES = 8 * HTB, NXCD = 8, WGM = 8;
__device__ __forceinline__ int lds_byte(int r, int c) { const int st = (r >> 4) * 2 + (c >> 5), rr = r & 15, cc = c & 31, ob = rr * 64 + cc * 2; return st * 1024 + (ob ^ (((ob >> 9) & 1) << 5)); }
__device__ __forceinline__ void stage_rc(int b, int& R, int& C) { const int st = b / 1024, sb = b % 1024, swz = sb ^ (((sb >> 9) & 1) << 5); R = (st >> 1) * 16 + swz / 64; C = (st & 1) * 32 + (swz % 64) / 2; }
__device__ __forceinline__ int perm32(int rho) { const int n = rho >> 4, i = rho & 15; return 8 * (i >> 2) + 4 * n + (i & 3); }

struct Unit { int pm, pn, src, nt, koff; };

struct Sched {
    int nM, nN, nwg, G, c, mode, extra, ks, ntfull;
    const char *A0, *A1, *B0, *B1; size_t tstep;
    __device__ __forceinline__ bool next(int i, Unit& u) const {
        const int ti = mode == 1 ? (i >> 1) : i; u.src = mode == 1 ? (i & 1) : 0; u.nt = ntfull; u.koff = 0;
        const long L = (long)ti * G + c;
        if (L >= nwg + extra) return false;
        if (L >= nwg) { const int e = (int)L - nwg;
            if (mode == 1) { if (i & 1) return false; const int tile = e >> 1; u.pm = 64 + (tile >> 3); u.pn = tile & 7; u.src = 4 + (e & 1); }
            else if (mode == 2) { const int tile = e / ks, kc = e % ks; u.pm = 64 + (tile >> 3); u.pn = tile & 7; u.src = 2 + kc; u.nt = 8; u.koff = kc * 1024; }
            else { u.pm = 64 + (e >> 1); u.pn = 8 + (e & 1); }
            return true; }
        int wgid = (int)L; { const int q = nwg / NXCD, r = nwg % NXCD, xcd = wgid % NXCD, off = wgid / NXCD; wgid = (xcd < r ? xcd * (q + 1) : r * (q + 1) + (xcd - r) * q) + off; }
        const int nig = WGM * nN, gid = wgid / nig, fm = gid * WGM, gsz = (nM - fm) < WGM ? (nM - fm) : WGM;
        u.pm = fm + ((wgid % nig) % gsz); u.pn = (wgid % nig) / gsz; return true;
    }
    __device__ __forceinline__ const char* a_base(const Unit& u) const { return ((u.src == 1 || u.src == 5) ? A1 : A0) + (size_t)u.pm * tstep + u.koff; }
    __device__ __forceinline__ const char* b_base(const Unit& u) const { return ((u.src == 1 || u.src == 5) ? B1 : B0) + (size_t)u.pn * tstep + u.koff; }
};

template <int NT, class Epi>
__device__ __forceinline__ void gemm_phase(LAS unsigned char* lds, const int K, const Sched& S, const Epi& E, const int wave_s) {
    int tid = tid_of(wave_s); asm volatile("" : "+v"(tid));
    const int wid = __builtin_amdgcn_readfirstlane(tid >> 6), lane = tid & 63, wr = wid >> 2, wc = wid & 3, fr = lane & 15, fq = lane >> 4;
    unsigned voffA[2], voffB[2];
#pragma unroll
    for (int i = 0; i < 2; ++i) { int R, C; stage_rc(tid * 16 + i * 8192, R, C); const int Rb = (R & ~31) + perm32(R & 31);
        voffA[i] = (unsigned)(R * K + C) * 2u; voffB[i] = (unsigned)(Rb * K + C) * 2u; }
    const size_t kstep = (size_t)(BK * 2);
    const size_t hstep = (size_t)HALF * K * 2;
    const unsigned ldsw = (unsigned)wid * 1024u;
    const int aoff = lds_byte(wr * 64 + fr, fq * 8), boff = lds_byte(wc * 32 + fr, fq * 8);
    const unsigned ldsa = (unsigned)(size_t)lds + (unsigned)aoff, ldsb = (unsigned)(size_t)lds + (unsigned)boff;
#define PG8_SA(b, h) (((b) * 2 + (h)) * HTB)
#define PG8_SB(b, h) ((4 + (b) * 2 + (h)) * HTB)
#define PG8_STAGE(bufoff, gbase, voff) do { _Pragma("unroll") for (int _i = 0; _i < 2; ++_i) \
        __builtin_amdgcn_global_load_lds((const unsigned*)((const char*)(gbase) + (voff)[_i]), (LAS unsigned*)(lds + (bufoff) + ldsw + _i * 8192), 16, 0, 0); } while (0)
#define PG8_DSR(dst, addr, off) asm volatile("ds_read_b128 %0, %1 offset:%2" : "=v"(dst) : "v"(addr), "n"(off))
#define PG8_LDA(dst, b, h) do { const unsigned _a = ldsa + PG8_SA(b, h); _Pragma("unroll") for (int m = 0; m < 4; ++m) _Pragma("unroll") for (int k = 0; k < 2; ++k) PG8_DSR(dst[m][k], _a, m * 2048 + k * 1024); } while (0)
#define PG8_LDB(dst, b, h) do { const unsigned _b = ldsb + PG8_SB(b, h); _Pragma("unroll") for (int n = 0; n < 2; ++n) _Pragma("unroll") for (int k = 0; k < 2; ++k) PG8_DSR(dst[n][k], _b, n * 2048 + k * 1024); } while (0)
#define PG8_MMA(ai, bj, At, Bt) do { __builtin_amdgcn_s_setprio(1); _Pragma("unroll") for (int m = 0; m < 4; ++m) _Pragma("unroll") for (int n = 0; n < 2; ++n) _Pragma("unroll") for (int k = 0; k < 2; ++k) \
        acc[ai][bj][m][n] = __builtin_amdgcn_mfma_f32_16x16x32_bf16(Bt[n][k], At[m][k], acc[ai][bj][m][n], 0, 0, 0); __builtin_amdgcn_s_setprio(0); } while (0)
#define PG8_WAIT_V(n) asm volatile("s_waitcnt vmcnt(" #n ")" ::: "memory")
#define PG8_WAIT_L(n) asm volatile("s_waitcnt lgkmcnt(" #n ")" ::: "memory")
#define PG8_BAR __builtin_amdgcn_s_barrier()
#define PG8_SCHED __builtin_amdgcn_sched_barrier(0)
    Unit cur, nxt; int ui = 0;
    if (!S.next(0, cur)) return;
    __builtin_amdgcn_s_waitcnt(0);
    f32x4 acc[2][2][4][2];
#pragma unroll
    for (int a = 0; a < 2; ++a)
#pragma unroll
        for (int b = 0; b < 2; ++b)
#pragma unroll
            for (int m = 0; m < 4; ++m)
#pragma unroll
                for (int n = 0; n < 2; ++n) acc[a][b][m][n] = (f32x4){0.f, 0.f, 0.f, 0.f};
    bf16x8 At[4][2], B0[2][2], B1[2][2];
    const char* cA = S.a_base(cur); const char* cB = S.b_base(cur);
    PG8_STAGE(PG8_SB(0, 0), cB, voffB); PG8_STAGE(PG8_SB(0, 1), cB + hstep, voffB); PG8_STAGE(PG8_SA(0, 0), cA, voffA); PG8_STAGE(PG8_SA(0, 1), cA + hstep, voffA);
    if (wr == 1) PG8_BAR;
    PG8_WAIT_V(2); PG8_BAR;
    PG8_STAGE(PG8_SB(1, 0), cB + kstep, voffB); PG8_STAGE(PG8_SA(1, 0), cA + kstep, voffA); PG8_STAGE(PG8_SB(1, 1), cB + hstep + kstep, voffB);
    PG8_WAIT_V(6); PG8_BAR;
    for (;;) {
        const bool has_next = S.next(ui + 1, nxt);
        const char* nA = has_next ? S.a_base(nxt) : cA; const char* nB = has_next ? S.b_base(nxt) : cB;
        constexpr int nt = NT;
        for (int t = 0; t < nt; t += 2) {
            const bool last = (t == nt - 2);
            asm volatile(".p2align 4" ::: "memory");
            const char* a1 = cA + (size_t)(t + 1) * kstep;
            const char* a2 = last ? nA : cA + (size_t)(t + 2) * kstep; const char* b2 = last ? nB : cB + (size_t)(t + 2) * kstep;
            const char* a3 = a2 + kstep; const char* b3 = b2 + kstep;
            PG8_LDB(B0, 0, 0); PG8_LDB(B1, 0, 1); PG8_SCHED; PG8_LDA(At, 0, 0); PG8_STAGE(PG8_SA(1, 1), a1 + hstep, voffA);
            PG8_WAIT_V(8); PG8_WAIT_L(0); PG8_BAR; PG8_MMA(0, 0, At, B0); PG8_MMA(0, 1, At, B1); PG8_BAR; PG8_SCHED;
            PG8_LDA(At, 0, 1); PG8_STAGE(PG8_SB(0, 0), b2, voffB); PG8_STAGE(PG8_SB(0, 1), b2 + hstep, voffB); PG8_STAGE(PG8_SA(0, 0), a2, voffA);
            PG8_WAIT_V(8); PG8_WAIT_L(0); PG8_BAR; PG8_MMA(1, 0, At, B0); PG8_MMA(1, 1, At, B1); PG8_BAR; PG8_SCHED;
            PG8_LDB(B0, 1, 0); PG8_LDB(B1, 1, 1); PG8_SCHED; PG8_LDA(At, 1, 0); PG8_STAGE(PG8_SA(0, 1), a2 + hstep, voffA);
            PG8_WAIT_V(8); PG8_WAIT_L(0); PG8_BAR; PG8_MMA(0, 0, At, B0); PG8_MMA(0, 1, At, B1); PG8_BAR; PG8_SCHED;
            PG8_LDA(At, 1, 1); PG8_STAGE(PG8_SB(1, 0), b3, voffB); PG8_STAGE(PG8_SB(1, 1), b3 + hstep, voffB); PG8_STAGE(PG8_SA(1, 0), a3, voffA);
            PG8_WAIT_V(8); PG8_WAIT_L(0); PG8_BAR; PG8_MMA(1, 0, At, B0); PG8_MMA(1, 1, At, B1); PG8_BAR; PG8_SCHED;
        }
        if (wr == 0) PG8_BAR;
        const bool keep = E(acc, cur, wr, wc, fr, fq);
        __builtin_amdgcn_s_waitcnt(0x0F70);
        if (!has_next) break;
        if (!keep) {
#pragma unroll
            for (int a = 0; a < 2; ++a)
#pragma unroll
                for (int b = 0; b < 2; ++b)
#pragma unroll
                    for (int m = 0; m < 4; ++m)
#pragma unroll
                        for (int n = 0; n < 2; ++n) acc[a][b][m][n] = (f32x4){0.f, 0.f, 0.f, 0.f};
        }
        cur = nxt; cA = nA; cB = nB; ++ui;
        if (wr == 1) PG8_BAR;
    }
    PG8_WAIT_V(0);
    PG8_BAR;
#undef PG8_SA
#undef PG8_SB
#undef PG8_STAGE
#undef PG8_LDA
#undef PG8_DSR
#undef PG8_LDB
#undef PG8_MMA
#undef PG8_WAIT_V
#undef PG8_WAIT_L
#undef PG8_BAR
#undef PG8_SCHED
}
}
using pg8::Unit;

__device__ __forceinline__ u32x4 pack8(const f32x4 a, const f32x4 b) { u32x4 w; w.x = cvt_pk_bf16(a[0], a[1]); w.y = cvt_pk_bf16(a[2], a[3]); w.z = cvt_pk_bf16(b[0], b[1]); w.w = cvt_pk_bf16(b[2], b[3]); return w; }

struct EpiInProj {
    bf16_t *Q, *Kb, *Vb, *CB, *U, *RHO, *SC; const float* rope;
    __device__ __forceinline__ bool operator()(f32x4 (&acc)[2][2][4][2], const Unit& u, int wr, int wc, int fr, int fq) const {
        const int row0 = u.pm * 256 + wr * 64 + fr, pn = u.pn, cw = wc * 32 + fq * 8;
        if (pn <= 8) {
            bf16_t* dst = pn < 8 ? Q : Kb; const int ld = pn < 8 ? D : 256; const int cbase = pn < 8 ? pn * 256 : 0; const float sc = pn < 8 ? QSCALE : 1.0f;
            const bool lat = u.pm < 64;
#pragma unroll
            for (int ai = 0; ai < 2; ++ai) {
                f32x4 cvv[4], svv[4];
#pragma unroll
                for (int m = 0; m < 4; ++m) {
                    const int row = row0 + ai * 128 + m * 16; const int t = row & (SEQ - 1);
                    const int pos = (wc & 1) ? (t & 63) : (t >> 6);
                    cvv[m] = (f32x4){1.f, 1.f, 1.f, 1.f}; svv[m] = (f32x4){0.f, 0.f, 0.f, 0.f};
                    if (lat) { cvv[m] = *(const f32x4*)(rope + pos * 16 + 4 * fq); svv[m] = *(const f32x4*)(rope + 2048 + pos * 16 + 4 * fq); }
                }
                __builtin_amdgcn_sched_barrier(0);
#pragma unroll
                for (int m = 0; m < 4; ++m) {
                    const int row = row0 + ai * 128 + m * 16; const f32x4 cv = cvv[m], sv = svv[m];
#pragma unroll
                    for (int bj = 0; bj < 2; ++bj) {
                        const f32x4 x1 = acc[ai][bj][m][0], x2 = acc[ai][bj][m][1];
                        const f32x4 y1 = (x1 * cv - x2 * sv) * sc, y2 = (x2 * cv + x1 * sv) * sc;
                        *(u32x4*)(dst + (size_t)row * ld + cbase + bj * 128 + cw) = pack8(y1, y2);
                    }
                }
                __builtin_amdgcn_sched_barrier(0);
            }
        } else if (pn <= 17) {
            bf16_t* dst = pn == 9 ? Vb : CB; const int ld = pn == 9 ? 256 : D; const int cbase = pn == 9 ? 0 : (pn - 10) * 256;
#pragma unroll
            for (int ai = 0; ai < 2; ++ai)
#pragma unroll
                for (int m = 0; m < 4; ++m) {
                    const int row = row0 + ai * 128 + m * 16;
#pragma unroll
                    for (int bj = 0; bj < 2; ++bj) *(u32x4*)(dst + (size_t)row * ld + cbase + bj * 128 + cw) = pack8(acc[ai][bj][m][0], acc[ai][bj][m][1]);
                }
        } else if (pn <= 33) {
            const int cbase = (pn - 18) * 128 + cw;
#pragma unroll
            for (int ai = 0; ai < 2; ++ai)
#pragma unroll
                for (int m = 0; m < 4; ++m) {
                    const int row = row0 + ai * 128 + m * 16;
                    *(u32x4*)(U + (size_t)row * D + cbase) = pack8(acc[ai][0][m][0] * acc[ai][1][m][0], acc[ai][0][m][1] * acc[ai][1][m][1]);
                }
        } else {
            const int cbase = (pn - 34) * 128 + cw;
#pragma unroll
            for (int ai = 0; ai < 2; ++ai)
#pragma unroll
                for (int m = 0; m < 4; ++m) {
                    const int row = row0 + ai * 128 + m * 16;
                    f32x4 r0, r1, s0, s1;
#pragma unroll
                    for (int j = 0; j < 4; ++j) {
                        const float ea0 = __builtin_amdgcn_exp2f(-acc[ai][0][m][0][j] * LOG2E), ea1 = __builtin_amdgcn_exp2f(-acc[ai][0][m][1][j] * LOG2E);
                        const float ec0 = __builtin_amdgcn_exp2f(-acc[ai][1][m][0][j] * LOG2E), ec1 = __builtin_amdgcn_exp2f(-acc[ai][1][m][1][j] * LOG2E);
                        s0[j] = __builtin_amdgcn_rcpf(1.0f + ec0); s1[j] = __builtin_amdgcn_rcpf(1.0f + ec1);
                        r0[j] = (1.0f + ec0) * __builtin_amdgcn_rcpf(1.0f + ea0); r1[j] = (1.0f + ec1) * __builtin_amdgcn_rcpf(1.0f + ea1);
                    }
                    *(u32x4*)(RHO + (size_t)row * D + cbase) = pack8(r0, r1);
                    *(u32x4*)(SC + (size_t)row * D + cbase) = pack8(s0, s1);
                }
        }
        return false;
    }
};

struct EpiMerge {
    const bf16_t *RHO, *SC; bf16_t* Mo; float* part;
    __device__ __forceinline__ bool operator()(f32x4 (&acc)[2][2][4][2], const Unit& u, int wr, int wc, int fr, int fq) const {
        const int row0 = u.pm * 256 + wr * 64 + fr, c0 = u.pn * 256 + wc * 32 + fq * 8;
        const bf16_t* G = u.src == 0 ? RHO : SC;
        float* pd = part + (size_t)u.src * MC * D - (size_t)ML * D;
#pragma unroll
        for (int b4 = 0; b4 < 4; ++b4) {
            const int ai = b4 >> 1, mh = (b4 & 1) * 2;
            u32x4 gq[2][2];
#pragma unroll
            for (int mm = 0; mm < 2; ++mm)
#pragma unroll
                for (int bj = 0; bj < 2; ++bj) { const size_t ro = (size_t)(row0 + ai * 128 + (mh + mm) * 16) * D + c0 + bj * 128;
                    gq[mm][bj] = *(const u32x4*)(G + ro); }
            __builtin_amdgcn_sched_barrier(0);
#pragma unroll
            for (int mm = 0; mm < 2; ++mm)
#pragma unroll
                for (int bj = 0; bj < 2; ++bj) { const size_t ro = (size_t)(row0 + ai * 128 + (mh + mm) * 16) * D + c0 + bj * 128; const int m = mh + mm;
                    const u32x4 g = gq[mm][bj];
                    f32x4 g0 = (f32x4){bf_lo(g.x), bf_hi(g.x), bf_lo(g.y), bf_hi(g.y)}, g1 = (f32x4){bf_lo(g.z), bf_hi(g.z), bf_lo(g.w), bf_hi(g.w)};
                    if (u.src == 4) { const u32x4 r = *(const u32x4*)(RHO + ro);
                        g0 *= (f32x4){bf_lo(r.x), bf_hi(r.x), bf_lo(r.y), bf_hi(r.y)}; g1 *= (f32x4){bf_lo(r.z), bf_hi(r.z), bf_lo(r.w), bf_hi(r.w)}; }
                    acc[ai][bj][m][0] *= g0; acc[ai][bj][m][1] *= g1;
                    if (u.src == 1) *(u32x4*)(Mo + ro) = pack8(acc[ai][bj][m][0], acc[ai][bj][m][1]);
                    if (u.src >= 4) { *(f32x4*)(pd + ro) = acc[ai][bj][m][0]; *(f32x4*)(pd + ro + 4) = acc[ai][bj][m][1]; }
                }
            __builtin_amdgcn_sched_barrier(0);
        }
        return u.src == 0;
    }
};

struct EpiResid {
    bf16_t* xb; const float* gate; float* part;
    __device__ __forceinline__ bool operator()(f32x4 (&acc)[2][2][4][2], const Unit& u, int wr, int wc, int fr, int fq) const {
        if (u.src >= 2) {
            float* pd = part + (size_t)(u.src - 2) * MC * D + (size_t)((u.pm - 64) * 256 + wr * 64 + fr) * D + u.pn * 256 + wc * 32 + fq * 8;
#pragma unroll
            for (int ai = 0; ai < 2; ++ai)
#pragma unroll
                for (int m = 0; m < 4; ++m)
#pragma unroll
                    for (int bj = 0; bj < 2; ++bj) { float* q = pd + (size_t)(ai * 128 + m * 16) * D + bj * 128; *(f32x4*)q = acc[ai][bj][m][0]; *(f32x4*)(q + 4) = acc[ai][bj][m][1]; }
            return false;
        }
        const int vec = u.pm >> 5;
        const int row0 = u.pm * 256 + wr * 64 + fr, c0 = u.pn * 256 + wc * 32 + fq * 8;
        const float* gp = gate + vec * 12288 + c0;
        f32x4 gv[2][2];
#pragma unroll
        for (int bj = 0; bj < 2; ++bj) { gv[bj][0] = *(const f32x4*)(gp + bj * 128); gv[bj][1] = *(const f32x4*)(gp + bj * 128 + 4); }
#pragma unroll
        for (int b4 = 0; b4 < 4; ++b4) {
            const int ai = b4 >> 1, mh = (b4 & 1) * 2;
            u32x4 xq[2][2];
#pragma unroll
            for (int mm = 0; mm < 2; ++mm)
#pragma unroll
                for (int bj = 0; bj < 2; ++bj) xq[mm][bj] = *(const u32x4*)(xb + (size_t)(row0 + ai * 128 + (mh + mm) * 16) * D + c0 + bj * 128);
            __builtin_amdgcn_sched_barrier(0);
#pragma unroll
            for (int mm = 0; mm < 2; ++mm)
#pragma unroll
                for (int bj = 0; bj < 2; ++bj)
                { const u32x4 q = xq[mm][bj]; const f32x4 x0 = (f32x4){bf_lo(q.x), bf_hi(q.x), bf_lo(q.y), bf_hi(q.y)}, x1 = (f32x4){bf_lo(q.z), bf_hi(q.z), bf_lo(q.w), bf_hi(q.w)};
                    *(u32x4*)(xb + (size_t)(row0 + ai * 128 + (mh + mm) * 16) * D + c0 + bj * 128) = pack8(x0 + gv[bj][0] * acc[ai][bj][mh + mm][0], x1 + gv[bj][1] * acc[ai][bj][mh + mm][1]); }
            __builtin_amdgcn_sched_barrier(0);
        }
        return false;
    }
};

struct EpiSwiglu {
    bf16_t* HID;
    __device__ __forceinline__ bool operator()(f32x4 (&acc)[2][2][4][2], const Unit& u, int wr, int wc, int fr, int fq) const {
        const int row0 = u.pm * 256 + wr * 64 + fr, c0 = u.pn * 128 + wc * 32 + fq * 8;
#pragma unroll
        for (int ai = 0; ai < 2; ++ai)
#pragma unroll
            for (int m = 0; m < 4; ++m) {
                f32x4 h0, h1;
#pragma unroll
                for (int j = 0; j < 4; ++j) {
                    const float g0 = acc[ai][0][m][0][j], g1 = acc[ai][0][m][1][j];
                    h0[j] = g0 * fast_sigmoid(g0) * acc[ai][1][m][0][j]; h1[j] = g1 * fast_sigmoid(g1) * acc[ai][1][m][1][j];
                }
                *(u32x4*)(HID + (size_t)(row0 + ai * 128 + m * 16) * DFF + c0) = pack8(h0, h1);
            }
        return false;
    }
};

struct Args {
    const float* in[18]; float* out; unsigned char* ws; int ph_lo, ph_hi;
};

__device__ __forceinline__ int src_group_base(int kind, int n0, bool& ropeperm) {
    ropeperm = false;
    if (kind == 0) return n0;
    const int pn = n0 >> 8, off = n0 & 255;
    if (kind == 1) {
        if (pn <= 8) { ropeperm = true; return n0; }
        if (pn <= 17) return n0;
        if (pn <= 33) { const int j = pn - 18; return off < 128 ? OFF_CC + 128 * j + off : OFF_CX + 128 * j + off - 128; }
        const int j = pn - 34; return off < 128 ? OFF_GA + 128 * j + off : OFF_GC + 128 * j + off - 128;
    }
    return off < 128 ? 128 * pn + off : DFF + 128 * pn + off - 128;
}
__device__ __forceinline__ void transpose_item(const float* W, int K, int N, int NP, int kind, bf16_t* WT, LAS float* scr, int item, int lane) {
    const int nblk = NP / 32, kb = item / nblk, nb = item % nblk, k0 = 64 * kb, n0 = 32 * nb;
    bool rp; const int sb = src_group_base(kind, n0, rp);
    const int p = lane & 31; const int so = rp ? (4 * (p >> 3) + (p & 3) + 16 * ((p >> 2) & 1)) : p;
#pragma unroll 8
    for (int i = 0; i < 32; ++i) { const int kk = 2 * i + (lane >> 5); scr[kk * 33 + p] = W[(size_t)(k0 + kk) * N + sb + so]; }
    asm volatile("s_waitcnt lgkmcnt(0)" ::: "memory");
    const int c = lane & 7;
#pragma unroll
    for (int j = 0; j < 4; ++j) { const int n = (lane >> 3) + 8 * j; const LAS float* s = scr + (8 * c) * 33 + n;
        u32x4 o; o.x = cvt_pk_bf16(s[0 * 33], s[1 * 33]); o.y = cvt_pk_bf16(s[2 * 33], s[3 * 33]); o.z = cvt_pk_bf16(s[4 * 33], s[5 * 33]); o.w = cvt_pk_bf16(s[6 * 33], s[7 * 33]);
        *(u32x4*)(WT + (size_t)(n0 + n) * K + k0 + 8 * c) = o; }
    asm volatile("s_waitcnt lgkmcnt(0)" ::: "memory");
}

__device__ __forceinline__ void sincos_f32(float ang, float& sn, float& cs) {
    const float k = rintf(ang * 0.15915494309189535f);
    float r = fmaf(-k, 6.28125f, ang); r = fmaf(-k, 1.935307179586232e-3f, r);
    const float r2 = r * r;
    float ps = -1.0f / 51090942171709440000.0f;
    ps = fmaf(ps, r2, 1.0f / 121645100408832000.0f); ps = fmaf(ps, r2, -1.0f / 355687428096000.0f); ps = fmaf(ps, r2, 1.0f / 1307674368000.0f);
    ps = fmaf(ps, r2, -1.0f / 6227020800.0f); ps = fmaf(ps, r2, 1.0f / 39916800.0f); ps = fmaf(ps, r2, -1.0f / 362880.0f); ps = fmaf(ps, r2, 1.0f / 5040.0f);
    ps = fmaf(ps, r2, -1.0f / 120.0f); ps = fmaf(ps, r2, 1.0f / 6.0f); sn = fmaf(-r * r2, ps, r);
    float pc = 1.0f / 2432902008176640000.0f;
    pc = fmaf(pc, r2, -1.0f / 6402373705728000.0f); pc = fmaf(pc, r2, 1.0f / 20922789888000.0f); pc = fmaf(pc, r2, -1.0f / 87178291200.0f); pc = fmaf(pc, r2, 1.0f / 479001600.0f);
    pc = fmaf(pc, r2, -1.0f / 3628800.0f); pc = fmaf(pc, r2, 1.0f / 40320.0f); pc = fmaf(pc, r2, -1.0f / 720.0f); pc = fmaf(pc, r2, 1.0f / 24.0f); pc = fmaf(pc, r2, -0.5f);
    cs = fmaf(pc, r2, 1.0f);
}

constexpr int KSTR = 144, VSTR = 192;
constexpr int ATT_K = 0, ATT_V = 2 * 64 * KSTR;
__device__ __forceinline__ s16x4 vtr(const LAS unsigned char* p) { return __builtin_bit_cast(s16x4, __builtin_amdgcn_ds_read_tr16_b64_v4i16((LAS s16x4*)p)); }

__device__ __forceinline__ void attn_unit(LAS unsigned char* lds, const bf16_t* Q, const bf16_t* Kb, const bf16_t* Vb, bf16_t* O, const float* sink,
                                          int qrow0, int kvh, int crow0, int lrow0, int jlo, int jhi, int qpos0, const int wave_s) {
    int tid = tid_of(wave_s); asm volatile("" : "+v"(tid));
    const int wid = __builtin_amdgcn_readfirstlane(tid >> 6), lane = tid & 63, l31 = lane & 31, h = lane >> 5;
    const int head = kvh * 8 + wid;
    const int ntile = 4 + (jhi - jlo + 1);
    bf16x8 Qf[2][4];
#pragma unroll
    for (int qs = 0; qs < 2; ++qs)
#pragma unroll
        for (int ks = 0; ks < 4; ++ks) Qf[qs][ks] = *(const bf16x8*)(Q + (size_t)(qrow0 + 32 * qs + l31) * D + head * 64 + 16 * ks + 8 * h);
    const float sk = sink[head] * LOG2E;
    float mrow[2] = {sk, sk}, lsum[2] = {h == 0 ? 1.0f : 0.0f, h == 0 ? 1.0f : 0.0f};
    f32x16 Oacc[2][2];
#pragma unroll
    for (int qs = 0; qs < 2; ++qs)
#pragma unroll
        for (int dh = 0; dh < 2; ++dh)
#pragma unroll
            for (int r = 0; r < 16; ++r) Oacc[qs][dh][r] = 0.f;
    const int skey = tid >> 3, sch = tid & 7;
    const size_t gcol = (size_t)kvh * 64 + sch * 8;
    u32x4 kreg, vreg;
    { const int rb = crow0; kreg = *(const u32x4*)(Kb + (size_t)(rb + skey) * 256 + gcol); vreg = *(const u32x4*)(Vb + (size_t)(rb + skey) * 256 + gcol); }
    for (int ti = 0; ti < ntile; ++ti) {
        LAS unsigned char* kb = lds + ATT_K + (ti & 1) * 64 * KSTR; LAS unsigned char* vb = lds + ATT_V + (ti & 1) * 64 * VSTR;
        *(LAS u32x4*)(kb + skey * KSTR + sch * 16) = kreg; *(LAS u32x4*)(vb + skey * VSTR + sch * 16) = vreg;
        __syncthreads();
        if (ti + 1 < ntile) { const int tn = ti + 1; const int rb = tn < 4 ? crow0 + 64 * tn : lrow0 + 64 * (jlo + tn - 4);
            kreg = *(const u32x4*)(Kb + (size_t)(rb + skey) * 256 + gcol); vreg = *(const u32x4*)(Vb + (size_t)(rb + skey) * 256 + gcol); }
        const int jl = ti < 4 ? -1 : jlo + ti - 4;
        const bool masked = (jl == 0) || (jl == 4);
        const int kp0 = qpos0 - 128 + 64 * jl;
        bf16x8 Kf[2][4];
#pragma unroll
        for (int kt = 0; kt < 2; ++kt)
#pragma unroll
            for (int ks = 0; ks < 4; ++ks) Kf[kt][ks] = *(const LAS bf16x8*)(kb + (32 * kt + l31) * KSTR + (16 * ks + 8 * h) * 2);
#pragma unroll
        for (int qs = 0; qs < 2; ++qs) {
            f32x16 S[2];
#pragma unroll
            for (int kt = 0; kt < 2; ++kt) {
#pragma unroll
                for (int r = 0; r < 16; ++r) S[kt][r] = 0.f;
#pragma unroll
                for (int ks = 0; ks < 4; ++ks) S[kt] = __builtin_amdgcn_mfma_f32_32x32x16_bf16(Kf[kt][ks], Qf[qs][ks], S[kt], 0, 0, 0);
            }
            if (masked) {
                const int qp = qpos0 + 32 * qs + l31;
#pragma unroll
                for (int kt = 0; kt < 2; ++kt)
#pragma unroll
                    for (int r = 0; r < 16; ++r) { const int dlt = kp0 + 32 * kt + (r & 3) + 8 * (r >> 2) + 4 * h - qp; if (dlt > 128 || dlt < -128) S[kt][r] = -INFINITY; }
            }
            float mx = S[0][0];
#pragma unroll
            for (int kt = 0; kt < 2; ++kt)
#pragma unroll
                for (int r = 0; r < 16; ++r) mx = fmaxf(mx, S[kt][r]);
            mx = fmaxf(mx, xor_lane(mx, lane, 32));
            const float mnew = fmaxf(mrow[qs], mx);
            const float alpha = __builtin_amdgcn_exp2f(mrow[qs] - mnew);
            mrow[qs] = mnew;
            float ps = 0.f;
#pragma unroll
            for (int kt = 0; kt < 2; ++kt)
#pragma unroll
                for (int r = 0; r < 16; ++r) { S[kt][r] = __builtin_amdgcn_exp2f(S[kt][r] - mnew); ps += S[kt][r]; }
            lsum[qs] = lsum[qs] * alpha + ps;
#pragma unroll
            for (int dh = 0; dh < 2; ++dh)
#pragma unroll
                for (int r = 0; r < 16; ++r) Oacc[qs][dh][r] *= alpha;
#pragma unroll
            for (int s = 0; s < 4; ++s) {
                const int kt = s >> 1, sp = s & 1;
                u32x4 pw; pw.x = cvt_pk_bf16(S[kt][8 * sp + 0], S[kt][8 * sp + 1]); pw.y = cvt_pk_bf16(S[kt][8 * sp + 2], S[kt][8 * sp + 3]);
                pw.z = cvt_pk_bf16(S[kt][8 * sp + 4], S[kt][8 * sp + 5]); pw.w = cvt_pk_bf16(S[kt][8 * sp + 6], S[kt][8 * sp + 7]);
                const bf16x8 Pf = __builtin_bit_cast(bf16x8, pw);
#pragma unroll
                for (int dh = 0; dh < 2; ++dh) {
                    const int g1 = (lane >> 4) & 1, li = lane & 15, q4 = li >> 2, p4 = li & 3;
                    const LAS unsigned char* va = vb + (16 * s + 4 * h + q4) * VSTR + (32 * dh + 16 * g1 + 4 * p4) * 2;
                    const s16x4 lo = vtr(va), hi = vtr(va + 8 * VSTR);
                    const bf16x8 Vf = (bf16x8){lo[0], lo[1], lo[2], lo[3], hi[0], hi[1], hi[2], hi[3]};
                    Oacc[qs][dh] = __builtin_amdgcn_mfma_f32_32x32x16_bf16(Vf, Pf, Oacc[qs][dh], 0, 0, 0);
                }
            }
        }
    }
#pragma unroll
    for (int qs = 0; qs < 2; ++qs) {
        const float lt = lsum[qs] + xor_lane(lsum[qs], lane, 32);
        const float inv = 1.0f / lt;
        bf16_t* orow = O + (size_t)(qrow0 + 32 * qs + l31) * D + head * 64;
#pragma unroll
        for (int dh = 0; dh < 2; ++dh)
#pragma unroll
            for (int rg = 0; rg < 4; ++rg) {
                u32x2 w; w.x = cvt_pk_bf16(Oacc[qs][dh][4 * rg + 0] * inv, Oacc[qs][dh][4 * rg + 1] * inv); w.y = cvt_pk_bf16(Oacc[qs][dh][4 * rg + 2] * inv, Oacc[qs][dh][4 * rg + 3] * inv);
                *(u32x2*)(orow + 32 * dh + 8 * rg + 4 * h) = w;
            }
    }
    __syncthreads();
}


#define XB_TMO      128
#define XB_XCNT(j)  (256  + 64 * (j))
#define XB_XSUB(j)  (1280 + 64 * (j))
#define XB_XGEN(j)  (2304 + 64 * (j))
#define XB_TOP      3328
#define XB_TOPGEN   3392
#define XCD_BAR_WORDS 3456
#define XB_SPIN_CAP (1u << 18)
__device__ __forceinline__ unsigned xb_ld(unsigned* p)              { return __hip_atomic_load(p, __ATOMIC_RELAXED, __HIP_MEMORY_SCOPE_AGENT); }
__device__ __forceinline__ unsigned xb_add(unsigned* p, unsigned v) { return __hip_atomic_fetch_add(p, v, __ATOMIC_RELAXED, __HIP_MEMORY_SCOPE_AGENT); }
__device__ __forceinline__ unsigned xb_xcc_id() { return (unsigned)__builtin_amdgcn_s_getreg((3 << 11) | 20) & 0xFu; }
#define XB_SPIN(cond, bar) do { unsigned _sp = 0; while (cond) { __builtin_amdgcn_s_sleep(1); \
    if ((++_sp & 255u) == 0u) { if (xb_ld(&(bar)[XB_TMO])) break; if (_sp > XB_SPIN_CAP) { atomicAdd(&(bar)[XB_TMO], 1u); break; } } } } while (0)
struct XcdBarrier { unsigned* bar; unsigned x; volatile LAS unsigned* st; };
__device__ __forceinline__ XcdBarrier xcd_barrier_post(unsigned* bar, volatile LAS unsigned* st, const int wave_s) {
    XcdBarrier b; b.bar = bar; b.x = xb_xcc_id(); b.st = st;
    if (tid_of(wave_s) == 0) (void)xb_add(&bar[XB_XCNT(b.x)], 1u);
    return b;
}
__device__ __forceinline__ void xcd_barrier_complete(unsigned* bar, unsigned x, unsigned& nloc, unsigned& nx) {
    const unsigned G = gridDim.x * gridDim.y * gridDim.z;
    unsigned sum, cnt, mine, sp = 0u;
    for (;;) {
        sum = 0u; cnt = 0u; mine = 0u;
#pragma unroll
        for (unsigned j = 0; j < 16; ++j) { const unsigned c = xb_ld(&bar[XB_XCNT(j)]); sum += c; cnt += (c > 0u) ? 1u : 0u; mine = (j == x) ? c : mine; }
        if (sum == G) break;
        __builtin_amdgcn_s_sleep(1);
        if ((++sp & 255u) == 0u) { if (xb_ld(&bar[XB_TMO])) break; if (sp > XB_SPIN_CAP) { atomicAdd(&bar[XB_TMO], 1u); break; } }
    }
    nloc = mine > 0u ? mine : 1u; nx = cnt > 0u ? cnt : 1u;
}
__device__ __forceinline__ void xcd_barrier(const XcdBarrier& b, const int wave_s) {
    asm volatile("s_waitcnt vmcnt(0)" ::: "memory");
    __syncthreads();
    if (tid_of(wave_s) == 0) {
        unsigned* bar = b.bar;
        __builtin_amdgcn_s_waitcnt(0);
        unsigned nloc = b.st[0], nx = b.st[1];
        if (nloc == 0u) { xcd_barrier_complete(bar, b.x, nloc, nx); b.st[0] = nloc; b.st[1] = nx; }
        const unsigned old = xb_add(&bar[XB_XSUB(b.x)], 1u);
        const unsigned gen = old / nloc;
        if (old + 1u == (gen + 1u) * nloc) {
            __builtin_amdgcn_fence(__ATOMIC_RELEASE, "agent");
            asm volatile("s_waitcnt vmcnt(0)" ::: "memory");
            const unsigned og = xb_add(&bar[XB_TOP], 1u);
            const unsigned tg = og / nx;
            if (og + 1u == (tg + 1u) * nx) xb_add(&bar[XB_TOPGEN], 1u);
            else XB_SPIN(xb_ld(&bar[XB_TOPGEN]) == tg, bar);
            __builtin_amdgcn_fence(__ATOMIC_ACQUIRE, "agent");
            xb_add(&bar[XB_XGEN(b.x)], 1u);
            asm volatile("s_waitcnt vmcnt(0)" ::: "memory");
        } else {
            XB_SPIN(xb_ld(&bar[XB_XGEN(b.x)]) == gen, bar);
            __builtin_amdgcn_fence(__ATOMIC_ACQUIRE, "agent");
            asm volatile("s_waitcnt vmcnt(0)" ::: "memory");
        }
    }
    __syncthreads();
}

constexpr int LDS_BYTES = 147456;
constexpr int NPHASE = 18;


#define x_in      (a.in[0])
#define c_in      (a.in[1])
#define ctx_in    (a.in[2])
#define cctx_in   (a.in[3])
#define ada_w     (a.in[4])
#define ada_b     (a.in[5])
#define norm1_g   (a.in[6])
#define norm2_g   (a.in[7])
#define w_in      (a.in[8])
#define conv_w    (a.in[9])
#define conv_b    (a.in[10])
#define sink      (a.in[11])
#define w_attn_out (a.in[12])
#define w_conv_out (a.in[13])
#define w_o       (a.in[14])
#define w_ffn_in  (a.in[15])
#define w_ffn_out (a.in[16])
#define final_g   (a.in[17])
#define out       (a.out)
#define ws        (a.ws)
#define ADA  ((float*)(ws + WS_ADA))
#define ROPE ((float*)(ws + WS_ROPE))
#define XC   ((float*)(ws + WS_XC))
#define Hb   ((bf16_t*)(ws + WS_H))
#define Qb   ((bf16_t*)(ws + WS_Q))
#define CBb  ((bf16_t*)(ws + WS_CB))
#define Ub   ((bf16_t*)(ws + WS_U))
#define RHOb ((bf16_t*)(ws + WS_RHO))
#define SCb  ((bf16_t*)(ws + WS_SC))
#define Kb   ((bf16_t*)(ws + WS_K))
#define Vb   ((bf16_t*)(ws + WS_V))
#define HIDb ((bf16_t*)(ws + WS_HID))
#define Mb   Ub
#define PARTb ((float*)(ws + WS_PART))
#define MPARTb ((float*)(ws + WS_MPART) - (size_t)4 * MC * D)
#define XBb  ((bf16_t*)(ws + WS_XB))
__global__ void __launch_bounds__(512, 2) fwd_kernel(const Args a) {
    extern __shared__ __attribute__((aligned(16))) unsigned char lds_raw[];
    LAS unsigned char* lds = (LAS unsigned char*)lds_raw;
    cg::grid_group grid = cg::this_grid();
    const int G = gridDim.x, bx = blockIdx.x;
    volatile LAS unsigned* lctl = (volatile LAS unsigned*)(lds + 131072);
    const int wave_s = __builtin_amdgcn_readfirstlane((int)threadIdx.x >> 6);
    if (tid_of(wave_s) < 16) lctl[tid_of(wave_s)] = 0u;
    __syncthreads();
    const XcdBarrier xbar = xcd_barrier_post((unsigned*)ws + 4096, lctl + 8, wave_s);
    for (int ph = a.ph_lo; ph < a.ph_hi; ++ph) {
        int tid = tid_of(wave_s); asm volatile("" : "+v"(tid));
        const int lane = tid & 63, wave = wave_s;
        const int gw = bx * 8 + wave, NGW = G * 8;
        if (ph == 0) {
          for (int rep = 0; rep < REP_P0; ++rep) {
            LAS float* scr = (LAS float*)(lds + wave * 16384);
            constexpr int I_IN = 32 * (NIN / 32), I_SQ = 32 * 64, I_F1 = 32 * (NF1 / 32), I_F2 = (DFF / 64) * 64, I_L = I_IN + 3 * I_SQ + I_F1 + I_F2;
            for (int it = gw; it < DEPTH * I_L; it += NGW) {
                const int l = it / I_L; int r = it % I_L; unsigned char* wl = ws + WS_W + (size_t)l * W_LAYER;
                if (r < I_IN) { transpose_item(w_in + (size_t)l * D * NIN, D, NIN, NIN, 1, (bf16_t*)(wl + W_IN), scr, r, lane); continue; } r -= I_IN;
                if (r < I_SQ) { transpose_item(w_attn_out + (size_t)l * D * D, D, D, D, 0, (bf16_t*)(wl + W_A), scr, r, lane); continue; } r -= I_SQ;
                if (r < I_SQ) { transpose_item(w_conv_out + (size_t)l * D * D, D, D, D, 0, (bf16_t*)(wl + W_C), scr, r, lane); continue; } r -= I_SQ;
                if (r < I_SQ) { transpose_item(w_o + (size_t)l * D * D, D, D, D, 0, (bf16_t*)(wl + W_O), scr, r, lane); continue; } r -= I_SQ;
                if (r < I_F1) { transpose_item(w_ffn_in + (size_t)l * D * NF1, D, NF1, NF1, 2, (bf16_t*)(wl + W_F1), scr, r, lane); continue; } r -= I_F1;
                transpose_item(w_ffn_out + (size_t)l * DFF * D, DFF, D, D, 0, (bf16_t*)(wl + W_F2), scr, r, lane);
            }
            __syncthreads();
            LAS float* sl = (LAS float*)lds;
            LAS float* red = (LAS float*)(lds + 3 * 2048 * 4);
            for (int i = tid; i < 3 * 2048; i += 512) { const int v = i >> 11, k = i & 2047; const float cv = v < 2 ? c_in[v * 2048 + k] : cctx_in[k]; sl[i] = cv / (1.0f + __expf(-cv)); }
            __syncthreads();
            for (int it = bx; it < DEPTH * 192; it += G) {
                const int l = it / 192, j0 = (it % 192) * 64;
                const float* wp = ada_w + (size_t)l * D * 12288 + (size_t)(wave * 256) * 12288 + j0 + lane;
                float a0 = 0.f, a1 = 0.f, a2 = 0.f;
#pragma unroll 8
                for (int k = 0; k < 256; ++k) { const float w = wp[(size_t)k * 12288]; const int kk = wave * 256 + k; a0 += sl[kk] * w; a1 += sl[2048 + kk] * w; a2 += sl[4096 + kk] * w; }
                red[(wave * 3 + 0) * 64 + lane] = a0; red[(wave * 3 + 1) * 64 + lane] = a1; red[(wave * 3 + 2) * 64 + lane] = a2;
                __syncthreads();
                if (tid < 192) { const int v = tid >> 6, jl = tid & 63; float s = ada_b[l * 12288 + j0 + jl];
#pragma unroll
                    for (int w8 = 0; w8 < 8; ++w8) s += red[(w8 * 3 + v) * 64 + jl];
                    ADA[(l * 3 + v) * 12288 + j0 + jl] = s; }
                __syncthreads();
            }
            if (bx == (G > 1 ? 1 : 0)) {
                for (int i = tid; i < 2048; i += 512) { const int pos = i >> 4, f = i & 15;
                    float fq_;
                    switch (f) { case 0: fq_ = 1.f; break; case 1: fq_ = 0.562341325f; break; case 2: fq_ = 0.316227766f; break; case 3: fq_ = 0.177827941f; break;
                        case 4: fq_ = 0.1f; break; case 5: fq_ = 0.0562341325f; break; case 6: fq_ = 0.0316227766f; break; case 7: fq_ = 0.0177827941f; break;
                        case 8: fq_ = 0.01f; break; case 9: fq_ = 0.00562341325f; break; case 10: fq_ = 0.00316227766f; break; case 11: fq_ = 0.00177827941f; break;
                        case 12: fq_ = 0.001f; break; case 13: fq_ = 0.000562341325f; break; case 14: fq_ = 0.000316227766f; break; default: fq_ = 0.000177827941f; break; }
                    float sn, cs; sincos_f32((float)pos * fq_, sn, cs); ROPE[i] = cs; ROPE[2048 + i] = sn; }
            }
          __syncthreads(); }
        } else if (ph == NPHASE - 1) {
            for (int m = gw; m < ML; m += NGW) {
                const u32x2* xq = (const u32x2*)(XBb + (size_t)m * D); f32x4* xr = (f32x4*)(out + (size_t)m * D) + lane; f32x4 v[8]; float ss = 0.f;
#pragma unroll
                for (int j = 0; j < 8; ++j) { const u32x2 q = xq[64 * j + lane]; v[j] = (f32x4){bf_lo(q.x), bf_hi(q.x), bf_lo(q.y), bf_hi(q.y)}; ss += (v[j].x * v[j].x + v[j].y * v[j].y) + (v[j].z * v[j].z + v[j].w * v[j].w); }
                const float rs = rsqrtf(wave_sum(ss, lane) * (1.0f / D) + EPS);
#pragma unroll
                for (int j = 0; j < 8; ++j) { const f32x4 g = ((const f32x4*)final_g)[64 * j + lane]; xr[64 * j] = v[j] * rs * g; }
            }
        } else {
            const int l = (ph - 1) / 8, sp = (ph - 1) % 8;
            unsigned char* wl = ws + WS_W + (size_t)l * W_LAYER;
            const float* ada = ADA + (size_t)l * 3 * 12288;
            const float* xc_cur = l == 0 ? ctx_in : XC;
            if (sp == 0 || sp == 5) {
                const float* xl = x_in; const float* xc = sp == 0 ? xc_cur : XC; const bool lbf = !(sp == 0 && l == 0);
                const float* ng = (sp == 0 ? norm1_g : norm2_g) + l * D; const int so = sp == 0 ? 0 : 3 * 2048;
                const int mend = (sp == 5 && l == DEPTH - 1) ? ML : MT;
                const int nks = (sp == 5 && l == 0) ? 4 : ((sp == 0 && l == 1) ? 11 : 0);
                const float* pgate = ADA + 2 * 12288 + (sp == 5 ? 2 * 2048 : 5 * 2048);
                const float* xcs = (sp == 5 && l == 0) ? ctx_in : xc;
                const int NWC = nks > 4 ? 512 : 256; const bool cw_ = nks > 0 && gw < NWC && NGW > 2 * NWC, lw_ = nks > 0 && !cw_ && NGW > 2 * NWC;
                const int m_beg = cw_ ? ML + gw : (lw_ ? gw - NWC : gw), m_str = cw_ ? NWC : (lw_ ? NGW - NWC : NGW), m_end = cw_ ? MT : (lw_ ? ML : mend);
                const bool fastlat = lbf && !cw_ && (lw_ || nks == 0);
                if (fastlat) {
                    u32x2 nq[8];
                    { const u32x2* xq0 = (const u32x2*)(XBb + (size_t)(m_beg < ML ? m_beg : 0) * D);
#pragma unroll
                        for (int j = 0; j < 8; ++j) nq[j] = xq0[64 * j + lane]; }
                    for (int m = m_beg; m < m_end; m += m_str) {
                        const float* shp = ada + (m >> 13) * 12288 + so; const float* scp = shp + 2048;
                        f32x4 v[8]; float ss = 0.f;
#pragma unroll
                        for (int j = 0; j < 8; ++j) { const u32x2 q = nq[j]; v[j] = (f32x4){bf_lo(q.x), bf_hi(q.x), bf_lo(q.y), bf_hi(q.y)}; }
                        if (m + m_str < m_end) { const u32x2* xqn = (const u32x2*)(XBb + (size_t)(m + m_str) * D);
#pragma unroll
                            for (int j = 0; j < 8; ++j) nq[j] = xqn[64 * j + lane]; }
                        __builtin_amdgcn_sched_barrier(0);
#pragma unroll
                        for (int j = 0; j < 8; ++j) ss += (v[j].x * v[j].x + v[j].y * v[j].y) + (v[j].z * v[j].z + v[j].w * v[j].w);
                        const float rs = rsqrtf(wave_sum(ss, lane) * (1.0f / D) + EPS);
                        u32x2* o8 = (u32x2*)(Hb + (size_t)m * D) + lane;
#pragma unroll
                        for (int j = 0; j < 8; ++j) { const f32x4 g = ((const f32x4*)ng)[64 * j + lane], sc = ((const f32x4*)scp)[64 * j + lane], sh = ((const f32x4*)shp)[64 * j + lane];
                            const f32x4 y = (v[j] * rs) * g * (sc + 1.0f) + sh; u32x2 w; w.x = cvt_pk_bf16(y.x, y.y); w.y = cvt_pk_bf16(y.z, y.w); o8[64 * j] = w; }
                    }
                } else
                for (int rep = 0; rep < REP_NORM; ++rep)
                for (int m = m_beg; m < m_end; m += m_str) {
                    const bool lat = m < ML; const float* xr = lat ? xl + (size_t)m * D : xcs + (size_t)(m - ML) * D; const int vec = lat ? (m >> 13) : 2;
                    const float* shp = ada + vec * 12288 + so; const float* scp = shp + 2048;
                    f32x4 v[8]; float ss = 0.f;
                    if (lat && lbf) { const u32x2* xq = (const u32x2*)(XBb + (size_t)m * D);
#pragma unroll
                        for (int j = 0; j < 8; ++j) { const u32x2 q = xq[64 * j + lane]; v[j] = (f32x4){bf_lo(q.x), bf_hi(q.x), bf_lo(q.y), bf_hi(q.y)}; }
                    } else {
#pragma unroll
                        for (int j = 0; j < 8; ++j) v[j] = ((const f32x4*)xr)[64 * j + lane];
                        if (lat) { u32x2* xw = (u32x2*)(XBb + (size_t)m * D);
#pragma unroll
                            for (int j = 0; j < 8; ++j) { u32x2 w; w.x = cvt_pk_bf16(v[j].x, v[j].y); w.y = cvt_pk_bf16(v[j].z, v[j].w); xw[64 * j + lane] = w; } }
                    }
                    if (!lat && nks > 0) {
                        f32x4 ps[8];
#pragma unroll
                        for (int j = 0; j < 8; ++j) ps[j] = (f32x4){0.f, 0.f, 0.f, 0.f};
#pragma unroll 2
                        for (int kc = 0; kc < nks; ++kc) { const f32x4* pp = (const f32x4*)(PARTb + (size_t)kc * MC * D + (size_t)(m - ML) * D);
#pragma unroll
                            for (int j = 0; j < 8; ++j) ps[j] += pp[64 * j + lane]; }
#pragma unroll
                        for (int j = 0; j < 8; ++j) { v[j] += ((const f32x4*)pgate)[64 * j + lane] * ps[j]; if (sp == 5) ((f32x4*)(XC + (size_t)(m - ML) * D))[64 * j + lane] = v[j]; }
                    }
#pragma unroll
                    for (int j = 0; j < 8; ++j) ss += (v[j].x * v[j].x + v[j].y * v[j].y) + (v[j].z * v[j].z + v[j].w * v[j].w);
                    const float rs = rsqrtf(wave_sum(ss, lane) * (1.0f / D) + EPS);
                    u32x2* o8 = (u32x2*)(Hb + (size_t)m * D) + lane;
#pragma unroll
                    for (int j = 0; j < 8; ++j) { const f32x4 g = ((const f32x4*)ng)[64 * j + lane], sc = ((const f32x4*)scp)[64 * j + lane], sh = ((const f32x4*)shp)[64 * j + lane];
                        const f32x4 y = (v[j] * rs) * g * (sc + 1.0f) + sh; u32x2 w; w.x = cvt_pk_bf16(y.x, y.y); w.y = cvt_pk_bf16(y.z, y.w); o8[64 * j] = w; }
                }
            } else if (sp == 1) {
                pg8::Sched S; S.G = G; S.c = bx; S.mode = 0; S.nN = NIN / 256; S.tstep = (size_t)256 * D * 2; S.ks = 1; S.ntfull = D / 64;
                if (l == DEPTH - 1) { S.nM = 64; S.nwg = 64 * S.nN; S.extra = 4; } else { S.nM = 66; S.nwg = 66 * S.nN; S.extra = 0; }
                S.A0 = S.A1 = (const char*)Hb; S.B0 = S.B1 = (const char*)(wl + W_IN);
                EpiInProj E{Qb, Kb, Vb, CBb, Ub, RHOb, SCb, ROPE};
                for (int rep = 0; rep < REP_INPROJ; ++rep)
                pg8::gemm_phase<D / 64>(lds, D, S, E, wave_s);
            } else if (sp == 2) {
                const int nlat = BATCH * NKV * (SEQ / 64), nctx = (l == DEPTH - 1) ? 0 : BATCH * NKV * (CTXL / 64);
                for (int rep = 0; rep < REP_ATT; ++rep)
                for (int u = bx; u < nlat + nctx; u += G) {
                    if (u < nlat) { const int qb = u % (SEQ / 64), kvh = (u / (SEQ / 64)) % NKV, b = u / ((SEQ / 64) * NKV); const int q0 = qb * 64;
                        const int jlo = q0 >= 128 ? 0 : (q0 >= 64 ? 1 : 2); const int jhi = q0 + 192 <= SEQ ? 4 : (q0 + 128 <= SEQ ? 3 : 2);
                        attn_unit(lds, Qb, Kb, Vb, Hb, sink + l * 32, b * SEQ + q0, kvh, ML + b * CTXL, b * SEQ + q0 - 128, jlo, jhi, q0, wave_s);
                    } else { const int e = u - nlat; const int qb = e % 4, kvh = (e / 4) % NKV, b = e / 16;
                        attn_unit(lds, Qb, Kb, Vb, Hb, sink + l * 32, ML + b * CTXL + qb * 64, kvh, ML + b * CTXL, 0, 0, -1, 0, wave_s); }
                }
                const int mend = (l == DEPTH - 1) ? ML : MT;
                const float* cw = conv_w + l * 3 * D; const float* cbias = conv_b + l * D;
                for (int m = gw; m < mend; m += NGW) {
                    const bool lat = m < ML; const int t = lat ? (m & (SEQ - 1)) : ((m - ML) & (CTXL - 1)); const int tl = lat ? SEQ - 1 : CTXL - 1;
                    const bool hp = t > 0, hn = t < tl;
#pragma unroll
                    for (int j = 0; j < 4; ++j) {
                        const int c0 = (64 * j + lane) * 8; const size_t o = (size_t)m * D + c0;
                        const u32x4 zz = (u32x4){0u, 0u, 0u, 0u};
                        const u32x4 up = hp ? *(const u32x4*)(Ub + o - D) : zz, uc = *(const u32x4*)(Ub + o), un = hn ? *(const u32x4*)(Ub + o + D) : zz, cb = *(const u32x4*)(CBb + o);
                        const f32x4 w0a = *(const f32x4*)(cw + c0), w0b = *(const f32x4*)(cw + c0 + 4), w1a = *(const f32x4*)(cw + D + c0), w1b = *(const f32x4*)(cw + D + c0 + 4);
                        const f32x4 w2a = *(const f32x4*)(cw + 2 * D + c0), w2b = *(const f32x4*)(cw + 2 * D + c0 + 4), ba = *(const f32x4*)(cbias + c0), bb = *(const f32x4*)(cbias + c0 + 4);
#define UNPK_LO(q) ((f32x4){bf_lo(q.x), bf_hi(q.x), bf_lo(q.y), bf_hi(q.y)})
#define UNPK_HI(q) ((f32x4){bf_lo(q.z), bf_hi(q.z), bf_lo(q.w), bf_hi(q.w)})
                        const f32x4 ya = UNPK_LO(cb) * (w0a * UNPK_LO(up) + w1a * UNPK_LO(uc) + w2a * UNPK_LO(un) + ba);
                        const f32x4 yb = UNPK_HI(cb) * (w0b * UNPK_HI(up) + w1b * UNPK_HI(uc) + w2b * UNPK_HI(un) + bb);
#undef UNPK_LO
#undef UNPK_HI
                        *(u32x4*)(CBb + o) = pack8(ya, yb);
                    }
                }
            } else if (sp == 3) {
                pg8::Sched S; S.G = G; S.c = bx; S.mode = 1; S.nN = D / 256; S.tstep = (size_t)256 * D * 2; S.extra = 0; S.ks = 1; S.ntfull = D / 64;
                S.nM = 64; S.nwg = S.nM * S.nN; if (l == 0) S.extra = 32;
                S.A0 = (const char*)Hb; S.A1 = (const char*)CBb; S.B0 = (const char*)(wl + W_A); S.B1 = (const char*)(wl + W_C);
                EpiMerge E{RHOb, SCb, Mb, MPARTb};
                for (int rep = 0; rep < REP_MERGE; ++rep)
                pg8::gemm_phase<D / 64>(lds, D, S, E, wave_s);
            } else if (sp == 4) {
                pg8::Sched S; S.G = G; S.c = bx; S.nN = D / 256; S.tstep = (size_t)256 * D * 2; S.ntfull = D / 64;
                S.nM = 64; S.nwg = S.nM * S.nN; S.ks = 4; S.mode = 0; S.extra = 0;
                S.A0 = S.A1 = (const char*)Mb; S.B0 = S.B1 = (const char*)(wl + W_O);
                EpiResid E{XBb, ada + 2 * 2048, PARTb};
                if (l == 0) {
                    const float* p4 = MPARTb + (size_t)4 * MC * D; const float* p5 = MPARTb + (size_t)5 * MC * D;
                    for (int i = bx * 512 + tid; i < MC * D / 8; i += G * 512) {
                        const f32x4 a0 = *(const f32x4*)(p4 + (size_t)i * 8) + *(const f32x4*)(p5 + (size_t)i * 8), a1 = *(const f32x4*)(p4 + (size_t)i * 8 + 4) + *(const f32x4*)(p5 + (size_t)i * 8 + 4);
                        *(u32x4*)(Mb + (size_t)ML * D + (size_t)i * 8) = pack8(a0, a1); }
                }
                pg8::gemm_phase<D / 64>(lds, D, S, E, wave_s);
                if (l == 0) { xcd_barrier(xbar, wave_s); S.mode = 2; S.nwg = 0; S.extra = 16 * S.ks; S.c = (bx + 128) % G; pg8::gemm_phase<8>(lds, D, S, E, wave_s); }
            } else if (sp == 6) {
                pg8::Sched S; S.G = G; S.c = bx; S.mode = 0; S.nN = NF1 / 256; S.tstep = (size_t)256 * D * 2; S.extra = 0; S.ks = 1; S.ntfull = D / 64;
                S.nM = (l == DEPTH - 1) ? 64 : 66; S.nwg = S.nM * S.nN;
                S.A0 = S.A1 = (const char*)Hb; S.B0 = S.B1 = (const char*)(wl + W_F1);
                EpiSwiglu E{HIDb};
                for (int rep = 0; rep < REP_FFN1; ++rep)
                pg8::gemm_phase<D / 64>(lds, D, S, E, wave_s);
            } else if (sp == 7) {
                pg8::Sched S; S.G = G; S.c = bx; S.nN = D / 256; S.tstep = (size_t)256 * DFF * 2; S.ntfull = DFF / 64;
                S.nM = 64; S.nwg = S.nM * S.nN; S.ks = 11; S.mode = 0; S.extra = 0;
                S.A0 = S.A1 = (const char*)HIDb; S.B0 = S.B1 = (const char*)(wl + W_F2);
                EpiResid E{XBb, ada + 5 * 2048, PARTb};
                pg8::gemm_phase<DFF / 64>(lds, DFF, S, E, wave_s);
                if (l == 0) { S.mode = 2; S.nwg = 0; S.extra = 16 * S.ks; pg8::gemm_phase<8>(lds, DFF, S, E, wave_s); }
            }
        }
        if (ph + 1 < a.ph_hi) for (int rep = 0; rep < REP_SYNC; ++rep) { if (a.ph_hi > 1000) grid.sync(); else xcd_barrier(xbar, wave_s); }
    }
}

#undef x_in
#undef c_in
#undef ctx_in
#undef cctx_in
#undef ada_w
#undef ada_b
#undef norm1_g
#undef norm2_g
#undef w_in
#undef conv_w
#undef conv_b
#undef sink
#undef w_attn_out
#undef w_conv_out
#undef w_o
#undef w_ffn_in
#undef w_ffn_out
#undef final_g
#undef out
#undef ws
#undef ADA
#undef ROPE
#undef XC
#undef Hb
#undef Qb
#undef CBb
#undef Ub
#undef RHOb
#undef SCb
#undef Kb
#undef Vb
#undef HIDb
#undef Mb
#undef PARTb
#undef MPARTb
#undef XBb
extern "C" void kernel_launch(void* const* d_in, const int* in_sizes, int n_in, void* d_out, int out_size, void* d_ws, size_t ws_size, hipStream_t stream) {
    static int grid = 0;
    if (grid == 0) {
        if (n_in != 18 || out_size != ML * D || ws_size < WS_END) { fprintf(stderr, "kernel_launch: unexpected problem (n_in %d, out %d, ws %zu)\n", n_in, out_size, ws_size); grid = -1; return; }
        int dev = 0, cus = 0, per_cu = 0;
        (void)hipGetDevice(&dev); (void)hipDeviceGetAttribute(&cus, hipDeviceAttributeMultiprocessorCount, dev);
        if (hipFuncSetAttribute((const void*)fwd_kernel, hipFuncAttributeMaxDynamicSharedMemorySize, LDS_BYTES) != hipSuccess) { fprintf(stderr, "kernel_launch: hipFuncSetAttribute failed\n"); grid = -1; return; }
        if (hipOccupancyMaxActiveBlocksPerMultiprocessor(&per_cu, (const void*)fwd_kernel, 512, LDS_BYTES) != hipSuccess || per_cu < 1) per_cu = 1;
        (void)hipGetLastError();
        grid = cus * 1;
    }
    if (grid < 0) return;
    (void)hipMemsetAsync(d_ws, 0, 65536, stream);
    Args a{};
    for (int i = 0; i < 18; ++i) a.in[i] = (const float*)d_in[i];
    a.out = (float*)d_out; a.ws = (unsigned char*)d_ws;
#if MK_MULTI
    for (int ph = 0; ph < NPHASE; ++ph) { a.ph_lo = ph; a.ph_hi = ph + 1; if (ph) (void)hipMemsetAsync(d_ws, 0, 65536, stream); hipLaunchKernelGGL(fwd_kernel, dim3(grid), dim3(512), LDS_BYTES, stream, a); }
#else
    a.ph_lo = 0; a.ph_hi = NPHASE;
    void* args[] = {&a};
    hipError_t e = hipLaunchCooperativeKernel((const void*)fwd_kernel, dim3(grid), dim3(512), args, LDS_BYTES, stream);
    if (e != hipSuccess) fprintf(stderr, "cooperative launch failed: %s (grid %d)\n", hipGetErrorString(e), grid);
#endif
}
```
